# Optimizing an MI355X kernel written in HIP

```python
import math
import jax, jax.numpy as jnp
from jax import lax
import numpy as np

D_MODEL = 1024
BATCH = 4
SEQ = 4096
DEPTH = 2

CHUNK = 64
HEAD_DIM = 64
D_CONV = D_MODEL // 2
N_SB_HEADS = 8
D_SB = N_SB_HEADS * HEAD_DIM
D_MIX = D_CONV + D_SB
CONV_WIDTH = 3
PLE_DIM = 256
Q_BLOCK = 128
N_IN = 4 * D_CONV + 4 * D_SB
EPS = 1e-6

kernel_name = "hybrid_shortconv_stickbreaking_ple"


def rmsnorm(x, g):
    xf = x.astype(jnp.float32)
    y = xf * lax.rsqrt(jnp.mean(xf * xf, axis=-1, keepdims=True) + EPS)
    return (y * g.astype(jnp.float32)).astype(x.dtype)


def group_rmsnorm(y, g, group):
    shp = y.shape
    yf = y.astype(jnp.float32).reshape(shp[:-1] + (shp[-1] // group, group))
    yf = yf * lax.rsqrt(jnp.mean(yf * yf, axis=-1, keepdims=True) + EPS)
    return (yf.reshape(shp) * g.astype(jnp.float32)).astype(y.dtype)


def causal_dwconv(u, w, b):
    s = u.shape[1]
    up = jnp.pad(u, ((0, 0), (CONV_WIDTH - 1, 0), (0, 0)))
    y = b
    for j in range(CONV_WIDTH):
        y = y + up[:, j:j + s, :] * w[j]
    return y


def stick_breaking_block(q_blk, k_pre, v_pre, t0):
    dh = q_blk.shape[-1]
    z = jnp.einsum('bqhd,bkhd->bhqk', q_blk.astype(jnp.float32), k_pre.astype(jnp.float32)) / math.sqrt(dh)
    qb, kl = q_blk.shape[1], k_pre.shape[1]
    t_idx = t0 + jnp.arange(qb)[:, None]
    s_idx = jnp.arange(kl)[None, :]
    mask = s_idx < t_idx
    log_1m = jnp.where(mask, jax.nn.log_sigmoid(-z), 0.0)
    rem = lax.cumsum(log_1m, axis=3, reverse=True) - log_1m
    a = jnp.where(mask, jnp.exp(jax.nn.log_sigmoid(z) + rem), 0.0)
    out = jnp.einsum('bhqk,bkhd->bqhd', a, v_pre.astype(jnp.float32))
    return out.astype(q_blk.dtype)


def stick_breaking_attention(q, k, v):
    s = q.shape[1]
    outs = []
    for blk in range(s // Q_BLOCK):
        t0 = blk * Q_BLOCK
        kend = t0 + Q_BLOCK
        outs.append(stick_breaking_block(q[:, t0:kend], k[:, :kend], v[:, :kend], t0))
    return jnp.concatenate(outs, axis=1)


def setup_inputs(seed: int = 0) -> dict:
    key = jax.random.key(seed)
    ks = jax.random.split(key, 14)
    f32 = jnp.float32
    x = jax.random.normal(ks[0], (BATCH, SEQ, D_MODEL), f32)
    p = jax.random.normal(ks[1], (DEPTH, BATCH, SEQ, PLE_DIM), f32)
    norm_g = 1.0 + 0.02 * jax.random.normal(ks[2], (DEPTH, D_MODEL), f32)
    w_in = jax.random.normal(ks[3], (DEPTH, D_MODEL, N_IN), f32) * D_MODEL ** -0.5
    conv_w = jax.random.normal(ks[4], (DEPTH, CONV_WIDTH, D_CONV), f32) * CONV_WIDTH ** -0.5
    conv_b = 0.02 * jax.random.normal(ks[5], (DEPTH, D_CONV), f32)
    branch_g = 1.0 + 0.02 * jax.random.normal(ks[6], (DEPTH, D_MIX), f32)
    w_out = jax.random.normal(ks[7], (DEPTH, D_MIX, D_MODEL), f32) * D_MIX ** -0.5
    ple_norm_g = 1.0 + 0.02 * jax.random.normal(ks[8], (DEPTH, D_MODEL), f32)
    w_pg = jax.random.normal(ks[9], (DEPTH, D_MODEL, D_MODEL), f32) * D_MODEL ** -0.5
    b_pg = 0.02 * jax.random.normal(ks[10], (DEPTH, D_MODEL), f32)
    w_pe = jax.random.normal(ks[11], (DEPTH, PLE_DIM, D_MODEL), f32) * PLE_DIM ** -0.5
    final_g = 1.0 + 0.02 * jax.random.normal(ks[12], (D_MODEL,), f32)
    return {"x": x, "p": p, "norm_g": norm_g, "w_in": w_in, "conv_w": conv_w,
            "conv_b": conv_b, "branch_g": branch_g, "w_out": w_out,
            "ple_norm_g": ple_norm_g, "w_pg": w_pg, "b_pg": b_pg, "w_pe": w_pe,
            "final_g": final_g}


def reference(x, p, norm_g, w_in, conv_w, conv_b, branch_g, w_out,
              ple_norm_g, w_pg, b_pg, w_pe, final_g):
    bsz, s, _ = x.shape
    for i in range(DEPTH):
        h = rmsnorm(x, norm_g[i])
        proj = h @ w_in[i]
        c_b, c_c, c_h, c_z, q, k, v, a_z = jnp.split(
            proj, [D_CONV, 2 * D_CONV, 3 * D_CONV, 4 * D_CONV,
                   4 * D_CONV + D_SB, 4 * D_CONV + 2 * D_SB, 4 * D_CONV + 3 * D_SB], axis=-1)
        y_c = c_b * causal_dwconv(c_c * c_h, conv_w[i], conv_b[i])
        qh = q.reshape(bsz, s, N_SB_HEADS, HEAD_DIM)
        kh = k.reshape(bsz, s, N_SB_HEADS, HEAD_DIM)
        vh = v.reshape(bsz, s, N_SB_HEADS, HEAD_DIM)
        y_a = stick_breaking_attention(qh, kh, vh).reshape(bsz, s, D_SB)
        y = group_rmsnorm(jnp.concatenate([y_c, y_a], axis=-1), branch_g[i], HEAD_DIM)
        y = y * jax.nn.silu(jnp.concatenate([c_z, a_z], axis=-1))
        x = x + y @ w_out[i]
        gate = jax.nn.sigmoid(rmsnorm(x, ple_norm_g[i]) @ w_pg[i] + b_pg[i])
        x = x + gate * (p[i] @ w_pe[i])
    return rmsnorm(x, final_g)
```

```cpp
#include <hip/hip_runtime.h>
#include <hip/hip_cooperative_groups.h>
#include <cstdio>
#include <cstdint>
#define GRID_SYNC() xcd_barrier(bar)
namespace cg = cooperative_groups;
namespace pg8 {
#define PG8_LAS __attribute__((address_space(3)))
typedef unsigned short bf16_t;
typedef short bf16x8 __attribute__((ext_vector_type(8)));
typedef float f32x4 __attribute__((ext_vector_type(4)));
typedef unsigned u32x4 __attribute__((ext_vector_type(4)));
constexpr int BM = 256, BK = 64, HALF = 128, HTB = HALF * BK * 2  , STAGE_BYTES = 8 * HTB, NXCD = 8, WGM = 8;

__host__ __device__ __forceinline__ int lds_byte(int r, int c) { const int st = (r >> 4) * 2 + (c >> 5), rr = r & 15, cc = c & 31, ob = rr * 64 + cc * 2; return st * 1024 + (ob ^ (((ob >> 9) & 1) << 5)); }
__host__ __device__ __forceinline__ void stage_rc(int b, int& R, int& C) { const int st = b / 1024, sb = b % 1024, swz = sb ^ (((sb >> 9) & 1) << 5); R = (st >> 1) * 16 + swz / 64; C = (st & 1) * 32 + (swz % 64) / 2; }
__host__ __device__ __forceinline__ int perm32(int rho) { const int n = rho >> 4, i = rho & 15; return 8 * (i >> 2) + 4 * n + (i & 3); }

struct Unit { int pm, pn; };
struct Gemm { const bf16_t* A; const bf16_t* Bt; int M, N, K; };

struct StaticOrder {
    int nM, nN, nwg, G, c;
    __host__ __device__ void init(int M, int N, int G_, int c_) { nM = M / BM; nN = N / BM; nwg = nM * nN; G = G_; c = c_; }
    __host__ __device__ bool next(int i, Unit& u) const {
        const long L = (long)i * G + c; if (L >= nwg) return false;
        int wgid = (int)L; { const int q = nwg / NXCD, r = nwg % NXCD, xcd = wgid % NXCD, off = wgid / NXCD; wgid = (xcd < r ? xcd * (q + 1) : r * (q + 1) + (xcd - r) * q) + off; }
        const int nig = WGM * nN, gid = wgid / nig, fm = gid * WGM, gsz = (nM - fm) < WGM ? (nM - fm) : WGM;
        u.pm = fm + ((wgid % nig) % gsz); u.pn = (wgid % nig) / gsz; return true;
    }
    __device__ __forceinline__ void a_ready(const Unit&) const {}
    __device__ __forceinline__ void done(const Unit&) const {}
};
__device__ __forceinline__ unsigned cvt_pk_bf16(float lo, float hi) { unsigned r; asm volatile("v_cvt_pk_bf16_f32 %0, %1, %2" : "=v"(r) : "v"(lo), "v"(hi)); return r; }
__device__ __forceinline__ float bf_lo(unsigned w) { return __uint_as_float(w << 16); }
__device__ __forceinline__ float bf_hi(unsigned w) { return __uint_as_float(w & 0xffff0000u); }
constexpr float RMS_EPS = 1e-6f;

struct EpiProj {
    static constexpr bool PERM = true, AFTER_DRAIN = false;
    bf16_t* P; const float* ss; const PG8_LAS float* rtab; int pm0;
    __device__ __forceinline__ void operator()(const f32x4 (&acc)[2][2][4][2], const Unit& u, int wr, int wc, int fr, int fq) const {
        const int colb = u.pn * BM + wc * 32 + 8 * fq;
        const float qs = (u.pn == 8 || u.pn == 9) ? 0.18033688011112042f : 1.0f;
        const bool isu = (u.pn >= 2 && u.pn <= 5);
#pragma unroll
        for (int ai = 0; ai < 2; ++ai)
#pragma unroll
            for (int m = 0; m < 4; ++m) {
                const int row = u.pm * BM + ai * HALF + wr * 64 + m * 16 + fr;
                const float r = (u.pm == pm0 ? rtab[ai * HALF + wr * 64 + m * 16 + fr] : rsqrtf(ss[row] * (1.0f / 1024.0f) + RMS_EPS)) * qs;
                if (isu) {
                    const f32x4 v0 = (acc[ai][0][m][0] * r) * (acc[ai][1][m][0] * r), v1 = (acc[ai][0][m][1] * r) * (acc[ai][1][m][1] * r);
                    u32x4 w; w.x = cvt_pk_bf16(v0[0], v0[1]); w.y = cvt_pk_bf16(v0[2], v0[3]); w.z = cvt_pk_bf16(v1[0], v1[1]); w.w = cvt_pk_bf16(v1[2], v1[3]);
                    *(u32x4*)(P + (size_t)row * 4096 + 512 + 128 * (u.pn - 2) + wc * 32 + 8 * fq) = w;
                } else {
#pragma unroll
                for (int bj = 0; bj < 2; ++bj) {
                    const int col = colb + bj * HALF;
                    const f32x4 v0 = acc[ai][bj][m][0] * r, v1 = acc[ai][bj][m][1] * r;
                    u32x4 w; w.x = cvt_pk_bf16(v0[0], v0[1]); w.y = cvt_pk_bf16(v0[2], v0[3]); w.z = cvt_pk_bf16(v1[0], v1[1]); w.w = cvt_pk_bf16(v1[2], v1[3]);
                    *(u32x4*)(P + (size_t)row * 4096 + col) = w;
                }
                }
            }
    }
};
struct EpiPlain {
    static constexpr bool PERM = true, AFTER_DRAIN = false;
    bf16_t* O; int ldc;
    __device__ __forceinline__ void operator()(const f32x4 (&acc)[2][2][4][2], const Unit& u, int wr, int wc, int fr, int fq) const {
        const int colb = u.pn * BM + wc * 32 + 8 * fq;
#pragma unroll
        for (int ai = 0; ai < 2; ++ai)
#pragma unroll
            for (int m = 0; m < 4; ++m) {
                const int row = u.pm * BM + ai * HALF + wr * 64 + m * 16 + fr;
#pragma unroll
                for (int bj = 0; bj < 2; ++bj) {
                    const int col = colb + bj * HALF;
                    const f32x4 v0 = acc[ai][bj][m][0], v1 = acc[ai][bj][m][1];
                    u32x4 w; w.x = cvt_pk_bf16(v0[0], v0[1]); w.y = cvt_pk_bf16(v0[2], v0[3]); w.z = cvt_pk_bf16(v1[0], v1[1]); w.w = cvt_pk_bf16(v1[2], v1[3]);
                    *(u32x4*)(O + (size_t)row * ldc + col) = w;
                }
            }
    }
};
template <bool XBF> struct EpiOut {
    static constexpr bool PERM = true, AFTER_DRAIN = false;
    const float* xin; const bf16_t* xinb; bf16_t* xb; float* ssn;
    __device__ __forceinline__ void operator()(const f32x4 (&acc)[2][2][4][2], const Unit& u, int wr, int wc, int fr, int fq) const {
        const int colb = u.pn * BM + wc * 32 + 8 * fq;
        float sq[2][4];
#pragma unroll
        for (int ai = 0; ai < 2; ++ai) {
            const int row0 = u.pm * BM + ai * HALF + wr * 64 + fr;
            f32x4 xa[4][2][2];
            if constexpr (XBF) {
                u32x4 xw[4][2];
#pragma unroll
                for (int m = 0; m < 4; ++m)
#pragma unroll
                    for (int bj = 0; bj < 2; ++bj) xw[m][bj] = __builtin_nontemporal_load((const u32x4*)(xinb + (size_t)(row0 + m * 16) * 1024 + colb + bj * HALF));
#pragma unroll
                for (int m = 0; m < 4; ++m)
#pragma unroll
                    for (int bj = 0; bj < 2; ++bj) { const u32x4 q = xw[m][bj];
                        xa[m][bj][0] = (f32x4){bf_lo(q.x), bf_hi(q.x), bf_lo(q.y), bf_hi(q.y)}; xa[m][bj][1] = (f32x4){bf_lo(q.z), bf_hi(q.z), bf_lo(q.w), bf_hi(q.w)}; }
            } else {
#pragma unroll
                for (int m = 0; m < 4; ++m)
#pragma unroll
                    for (int bj = 0; bj < 2; ++bj) { const size_t off = (size_t)(row0 + m * 16) * 1024 + colb + bj * HALF;
                        xa[m][bj][0] = __builtin_nontemporal_load((const f32x4*)(xin + off)); xa[m][bj][1] = __builtin_nontemporal_load((const f32x4*)(xin + off + 4)); }
            }
#pragma unroll
            for (int m = 0; m < 4; ++m) {
                float q = 0.f;
#pragma unroll
                for (int bj = 0; bj < 2; ++bj) {
                    const size_t off = (size_t)(row0 + m * 16) * 1024 + colb + bj * HALF;
                    const f32x4 v0 = acc[ai][bj][m][0] + xa[m][bj][0], v1 = acc[ai][bj][m][1] + xa[m][bj][1];
                    u32x4 w; w.x = cvt_pk_bf16(v0[0], v0[1]); w.y = cvt_pk_bf16(v0[2], v0[3]); w.z = cvt_pk_bf16(v1[0], v1[1]); w.w = cvt_pk_bf16(v1[2], v1[3]);
                    *(u32x4*)(xb + off) = w;
                    q += (v0[0] * v0[0] + v0[1] * v0[1]) + (v0[2] * v0[2] + v0[3] * v0[3]) + (v1[0] * v1[0] + v1[1] * v1[1]) + (v1[2] * v1[2] + v1[3] * v1[3]);
                }
                sq[ai][m] = q;
            }
        }
#pragma unroll
        for (int ai = 0; ai < 2; ++ai)
#pragma unroll
            for (int m = 0; m < 4; ++m) {
                float q = sq[ai][m]; q += __shfl_xor(q, 16); q += __shfl_xor(q, 32);
                if (fq == 0) atomicAdd(ssn + (u.pm * BM + ai * HALF + wr * 64 + m * 16 + fr), q);
            }
    }
};
struct EpiPg {
    static constexpr bool PERM = true, AFTER_DRAIN = false;
    const bf16_t* xin; float* xout; bf16_t* xb; const float* ss; float* ssn; const float* bias; const bf16_t* pe;
    __device__ __forceinline__ void operator()(const f32x4 (&acc)[2][2][4][2], const Unit& u, int wr, int wc, int fr, int fq) const {
        const int colb = u.pn * BM + wc * 32 + 8 * fq;
        f32x4 bv[2][2];
#pragma unroll
        for (int bj = 0; bj < 2; ++bj) { bv[bj][0] = *(const f32x4*)(bias + colb + bj * HALF); bv[bj][1] = *(const f32x4*)(bias + colb + bj * HALF + 4); }
        float rs[2][4], sq[2][4];
#pragma unroll
        for (int ai = 0; ai < 2; ++ai)
#pragma unroll
            for (int m = 0; m < 4; ++m) rs[ai][m] = ss[u.pm * BM + ai * HALF + wr * 64 + m * 16 + fr];
#pragma unroll
        for (int ai = 0; ai < 2; ++ai)
#pragma unroll
            for (int mp = 0; mp < 2; ++mp) {
                const int row0 = u.pm * BM + ai * HALF + wr * 64 + fr;
                u32x4 xw[2][2], pw[2][2];
#pragma unroll
                for (int mm = 0; mm < 2; ++mm)
#pragma unroll
                    for (int bj = 0; bj < 2; ++bj) { const size_t off = (size_t)(row0 + (2 * mp + mm) * 16) * 1024 + colb + bj * HALF;
                        xw[mm][bj] = *(const u32x4*)(xin + off); pw[mm][bj] = *(const u32x4*)(pe + off); }
#pragma unroll
                for (int mm = 0; mm < 2; ++mm) {
                    const int m = 2 * mp + mm;
                    const float r = rsqrtf(rs[ai][m] * (1.0f / 1024.0f) + RMS_EPS);
                    float q = 0.f;
#pragma unroll
                    for (int bj = 0; bj < 2; ++bj) {
                        const size_t off = (size_t)(row0 + m * 16) * 1024 + colb + bj * HALF;
                        const f32x4 t0 = acc[ai][bj][m][0] * r + bv[bj][0], t1 = acc[ai][bj][m][1] * r + bv[bj][1];
                        f32x4 g0, g1;
#pragma unroll
                        for (int e = 0; e < 4; ++e) { g0[e] = __builtin_amdgcn_rcpf(1.0f + __expf(-t0[e])); g1[e] = __builtin_amdgcn_rcpf(1.0f + __expf(-t1[e])); }
                        const u32x4 pq = pw[mm][bj];
                        const f32x4 p0 = (f32x4){bf_lo(pq.x), bf_hi(pq.x), bf_lo(pq.y), bf_hi(pq.y)}, p1 = (f32x4){bf_lo(pq.z), bf_hi(pq.z), bf_lo(pq.w), bf_hi(pq.w)};
                        const u32x4 xq = xw[mm][bj];
                        const f32x4 x0 = (f32x4){bf_lo(xq.x), bf_hi(xq.x), bf_lo(xq.y), bf_hi(xq.y)}, x1 = (f32x4){bf_lo(xq.z), bf_hi(xq.z), bf_lo(xq.w), bf_hi(xq.w)};
                        const f32x4 v0 = x0 + g0 * p0, v1 = x1 + g1 * p1;
                        if (xout) { *(f32x4*)(xout + off) = v0; *(f32x4*)(xout + off + 4) = v1; }
                        if (xb) { u32x4 w; w.x = cvt_pk_bf16(v0[0], v0[1]); w.y = cvt_pk_bf16(v0[2], v0[3]); w.z = cvt_pk_bf16(v1[0], v1[1]); w.w = cvt_pk_bf16(v1[2], v1[3]);
                            *(u32x4*)(xb + off) = w; }
                        q += (v0[0] * v0[0] + v0[1] * v0[1]) + (v0[2] * v0[2] + v0[3] * v0[3]) + (v1[0] * v1[0] + v1[1] * v1[1]) + (v1[2] * v1[2] + v1[3] * v1[3]);
                    }
                    sq[ai][m] = q;
                }
            }
#pragma unroll
        for (int ai = 0; ai < 2; ++ai)
#pragma unroll
            for (int m = 0; m < 4; ++m) {
                float q = sq[ai][m]; q += __shfl_xor(q, 16); q += __shfl_xor(q, 32);
                if (fq == 0) atomicAdd(ssn + (u.pm * BM + ai * HALF + wr * 64 + m * 16 + fr), q);
            }
    }
};

template <class Epi, class Sched, bool ALIGN_EPI = false, bool SP2 = false>
__device__ __forceinline__ void gemm_phase(PG8_LAS unsigned char* lds, const Gemm g, const Sched& S, const Epi& E) {
    int tid_ = threadIdx.x; asm volatile("" : "+v"(tid_));
    const int tid = tid_, wid = __builtin_amdgcn_readfirstlane(tid >> 6), lane = tid & 63, wr = wid >> 2, wc = wid & 3, fr = lane & 15, fq = lane >> 4;
    int K = g.K; asm volatile("" : "+s"(K)); const int nt = K / BK;
    unsigned voffA[2], voffB[2];
#pragma unroll
    for (int i = 0; i < 2; ++i) { int R, C; stage_rc(tid * 16 + i * 8192, R, C); const int Rb = Epi::PERM ? ((R & ~31) + perm32(R & 31)) : R;
        voffA[i] = (unsigned)(R * K + C) * 2u; voffB[i] = (unsigned)(Rb * K + C) * 2u; }
    const size_t kstep = (size_t)(BK * 2);
    const size_t hstep = (size_t)HALF * K * 2;
    const size_t tstep = 2 * hstep;
    const unsigned ldsw = (unsigned)wid * 1024u;
    const int aoff = lds_byte(wr * 64 + fr, fq * 8), boff = lds_byte(wc * 32 + fr, fq * 8);
#define PG8_SA(b, h) (((b) * 2 + (h)) * HTB)
#define PG8_SB(b, h) ((4 + (b) * 2 + (h)) * HTB)
#define PG8_STAGE(bufoff, gbase, voff) do { _Pragma("unroll") for (int _i = 0; _i < 2; ++_i) \
        __builtin_amdgcn_global_load_lds((const unsigned*)((const char*)(gbase) + (voff)[_i]), (PG8_LAS unsigned*)(lds + (bufoff) + ldsw + _i * 8192), 16, 0, 0); } while (0)
#define PG8_LDA(dst, b, h) do { _Pragma("unroll") for (int m = 0; m < 4; ++m) _Pragma("unroll") for (int k = 0; k < 2; ++k) dst[m][k] = *(const PG8_LAS bf16x8*)(lds + PG8_SA(b, h) + aoff + m * 2048 + k * 1024); } while (0)
#define PG8_LDB(dst, b, h) do { _Pragma("unroll") for (int n = 0; n < 2; ++n) _Pragma("unroll") for (int k = 0; k < 2; ++k) dst[n][k] = *(const PG8_LAS bf16x8*)(lds + PG8_SB(b, h) + boff + n * 2048 + k * 1024); } while (0)
#define PG8_MMA(ai, bj, At, Bt) do { __builtin_amdgcn_s_setprio(1); _Pragma("unroll") for (int m = 0; m < 4; ++m) _Pragma("unroll") for (int n = 0; n < 2; ++n) _Pragma("unroll") for (int k = 0; k < 2; ++k) \
        acc[ai][bj][m][n] = __builtin_amdgcn_mfma_f32_16x16x32_bf16(Bt[n][k], At[m][k], acc[ai][bj][m][n], 0, 0, 0); __builtin_amdgcn_s_setprio(0); } while (0)
#define PG8_WAIT_V(n) asm volatile("s_waitcnt vmcnt(" #n ")" ::: "memory")
#define PG8_WAIT_L(n) asm volatile("s_waitcnt lgkmcnt(" #n ")" ::: "memory")
#define PG8_BAR __builtin_amdgcn_s_barrier()
#define PG8_SCHED __builtin_amdgcn_sched_barrier(0)
    Unit cur, nxt; int ui = 0;
    if (!S.next(0, cur)) return;
    f32x4 acc[2][2][4][2];
#pragma unroll
    for (int a = 0; a < 2; ++a)
#pragma unroll
        for (int b = 0; b < 2; ++b)
#pragma unroll
            for (int m = 0; m < 4; ++m)
#pragma unroll
                for (int n = 0; n < 2; ++n) acc[a][b][m][n] = (f32x4){0.f, 0.f, 0.f, 0.f};
    bf16x8 At[4][2], B0[2][2], B1[2][2];
    const char* cA = (const char*)g.A + (size_t)cur.pm * tstep; const char* cB = (const char*)g.Bt + (size_t)cur.pn * tstep;
    S.a_ready(cur);
    if constexpr (SP2) {
        PG8_STAGE(PG8_SB(0, 0), cB, voffB); PG8_STAGE(PG8_SB(0, 1), cB + hstep, voffB); PG8_STAGE(PG8_SA(0, 0), cA, voffA); PG8_STAGE(PG8_SA(0, 1), cA + hstep, voffA);
        if (wr == 1) PG8_BAR;
        PG8_WAIT_V(2); PG8_BAR;
        PG8_STAGE(PG8_SB(1, 0), cB + kstep, voffB); PG8_STAGE(PG8_SA(1, 0), cA + kstep, voffA); PG8_STAGE(PG8_SB(1, 1), cB + hstep + kstep, voffB);
        PG8_WAIT_V(6); PG8_BAR;
    } else {
        PG8_STAGE(PG8_SB(0, 0), cB, voffB); PG8_STAGE(PG8_SA(0, 0), cA, voffA); PG8_STAGE(PG8_SB(0, 1), cB + hstep, voffB); PG8_STAGE(PG8_SA(0, 1), cA + hstep, voffA);
        if (wr == 1) PG8_BAR;
        PG8_WAIT_V(4); PG8_BAR;
        PG8_STAGE(PG8_SB(1, 0), cB + kstep, voffB); PG8_STAGE(PG8_SA(1, 0), cA + kstep, voffA); PG8_STAGE(PG8_SB(1, 1), cB + hstep + kstep, voffB);
        PG8_WAIT_V(6); PG8_BAR;
    }
    for (;;) {
        const bool has_next = S.next(ui + 1, nxt);
        const char* nA = has_next ? (const char*)g.A + (size_t)nxt.pm * tstep : cA; const char* nB = has_next ? (const char*)g.Bt + (size_t)nxt.pn * tstep : cB;
        for (int t = 0; t < nt; t += 2) {
            const bool last = (t == nt - 2);
            const char* a1 = cA + (size_t)(t + 1) * kstep;
            const char* a2 = last ? nA : cA + (size_t)(t + 2) * kstep; const char* b2 = last ? nB : cB + (size_t)(t + 2) * kstep;
            const char* a3 = a2 + kstep; const char* b3 = b2 + kstep;
            if (last && has_next) S.a_ready(nxt);
            if constexpr (SP2) {
            PG8_LDB(B0, 0, 0); PG8_LDB(B1, 0, 1); PG8_SCHED; PG8_LDA(At, 0, 0); PG8_STAGE(PG8_SA(1, 1), a1 + hstep, voffA);
            PG8_WAIT_V(8); PG8_WAIT_L(0); PG8_BAR; PG8_MMA(0, 0, At, B0); PG8_MMA(0, 1, At, B1); PG8_BAR; PG8_SCHED;
            PG8_LDA(At, 0, 1); PG8_STAGE(PG8_SB(0, 0), b2, voffB); PG8_STAGE(PG8_SB(0, 1), b2 + hstep, voffB); PG8_STAGE(PG8_SA(0, 0), a2, voffA);
            PG8_WAIT_V(8); PG8_WAIT_L(0); PG8_BAR; PG8_MMA(1, 0, At, B0); PG8_MMA(1, 1, At, B1); PG8_BAR; PG8_SCHED;
            PG8_LDB(B0, 1, 0); PG8_LDB(B1, 1, 1); PG8_SCHED; PG8_LDA(At, 1, 0); PG8_STAGE(PG8_SA(0, 1), a2 + hstep, voffA);
            PG8_WAIT_V(8); PG8_WAIT_L(0); PG8_BAR; PG8_MMA(0, 0, At, B0); PG8_MMA(0, 1, At, B1); PG8_BAR; PG8_SCHED;
            PG8_LDA(At, 1, 1); PG8_STAGE(PG8_SB(1, 0), b3, voffB); PG8_STAGE(PG8_SB(1, 1), b3 + hstep, voffB); PG8_STAGE(PG8_SA(1, 0), a3, voffA);
            PG8_WAIT_V(8); PG8_WAIT_L(0); PG8_BAR; PG8_MMA(1, 0, At, B0); PG8_MMA(1, 1, At, B1); PG8_BAR; PG8_SCHED;
            } else {
            PG8_LDB(B0, 0, 0); PG8_SCHED; PG8_LDA(At, 0, 0); PG8_STAGE(PG8_SA(1, 1), a1 + hstep, voffA);
            PG8_WAIT_L(8); PG8_BAR; PG8_WAIT_L(0); PG8_MMA(0, 0, At, B0); PG8_BAR; PG8_SCHED;
            PG8_LDB(B1, 0, 1); PG8_STAGE(PG8_SB(0, 0), b2, voffB);
            PG8_BAR; PG8_WAIT_L(0); PG8_MMA(0, 1, At, B1); PG8_BAR;
            PG8_LDA(At, 0, 1); PG8_STAGE(PG8_SA(0, 0), a2, voffA);
            PG8_BAR; PG8_WAIT_L(0); PG8_MMA(1, 0, At, B0); PG8_BAR; PG8_SCHED;
            PG8_STAGE(PG8_SB(0, 1), b2 + hstep, voffB);
            PG8_WAIT_V(6); PG8_BAR; PG8_MMA(1, 1, At, B1); PG8_BAR;
            PG8_LDB(B0, 1, 0); PG8_SCHED; PG8_LDA(At, 1, 0); PG8_STAGE(PG8_SA(0, 1), a2 + hstep, voffA);
            PG8_WAIT_L(8); PG8_BAR; PG8_WAIT_L(0); PG8_MMA(0, 0, At, B0); PG8_BAR; PG8_SCHED;
            PG8_LDB(B1, 1, 1); PG8_STAGE(PG8_SB(1, 0), b3, voffB);
            PG8_BAR; PG8_WAIT_L(0); PG8_MMA(0, 1, At, B1); PG8_BAR;
            PG8_LDA(At, 1, 1); PG8_STAGE(PG8_SA(1, 0), a3, voffA);
            PG8_BAR; PG8_WAIT_L(0); PG8_MMA(1, 0, At, B0); PG8_BAR; PG8_SCHED;
            PG8_STAGE(PG8_SB(1, 1), b3 + hstep, voffB);
            PG8_WAIT_V(6); PG8_BAR; PG8_MMA(1, 1, At, B1); PG8_BAR;
            }
        }
        if constexpr (ALIGN_EPI) { if (wr == 0) PG8_BAR; }
        if constexpr (!Epi::AFTER_DRAIN) { E(acc, cur, wr, wc, fr, fq); S.done(cur); }
        if (!has_next) break;
#pragma unroll
        for (int a = 0; a < 2; ++a)
#pragma unroll
            for (int b = 0; b < 2; ++b)
#pragma unroll
                for (int m = 0; m < 4; ++m)
#pragma unroll
                    for (int n = 0; n < 2; ++n) acc[a][b][m][n] = (f32x4){0.f, 0.f, 0.f, 0.f};
        cur = nxt; cA = nA; cB = nB; ++ui;
        if constexpr (ALIGN_EPI) { if (wr == 1) PG8_BAR; }
    }
    PG8_WAIT_V(0);
    if constexpr (!ALIGN_EPI) { if (wr == 0) PG8_BAR; }
    PG8_BAR;
    if constexpr (Epi::AFTER_DRAIN) { E.fused(acc, cur, wr, wc, fr, fq, lds, wid, lane); S.done(cur); }
#undef PG8_SA
#undef PG8_SB
#undef PG8_STAGE
#undef PG8_LDA
#undef PG8_LDB
#undef PG8_MMA
#undef PG8_WAIT_V
#undef PG8_WAIT_L
#undef PG8_BAR
#undef PG8_SCHED
}
}

typedef pg8::bf16_t bf16;
typedef pg8::f32x4 f32x4;
typedef pg8::u32x4 u32x4;
#define LAS __attribute__((address_space(3)))
constexpr int NWAVES = 8, NTHREADS = NWAVES * 64;
constexpr int M = 16384, D = 1024, NIN = 4096, SEQ = 4096, PLE = 256, DEPTH = 2;
constexpr int LDS_BYTES = 131072 + 64 + 1024;
constexpr size_t MiB = 1024 * 1024;
constexpr size_t WS_PROJ = 0;
constexpr size_t WS_VT   = 128 * MiB;
constexpr size_t WS_XB   = 144 * MiB;
constexpr size_t WS_XB2  = 176 * MiB;
constexpr size_t WS_PB   = 208 * MiB;
constexpr size_t WS_WT   = 224 * MiB;
constexpr size_t WT_LAYER = 12 * MiB + 512 * 1024, WT_OUT = 8 * MiB, WT_PG = 10 * MiB, WT_PE = 12 * MiB;
constexpr size_t WS_SS   = 250 * MiB;
constexpr size_t WS_BAR  = 250 * MiB + 512 * 1024;
constexpr size_t WS_BAR_BYTES = 16384;
constexpr size_t WS_END  = 251 * MiB;

struct Args {
    const float* x; const float* p; const float* norm_g; const float* w_in; const float* conv_w; const float* conv_b; const float* branch_g;
    const float* w_out; const float* ple_norm_g; const float* w_pg; const float* b_pg; const float* w_pe; const float* final_g;
    float* out; unsigned char* ws;
};

__device__ __forceinline__ unsigned pk2(float lo, float hi) { return pg8::cvt_pk_bf16(lo, hi); }
__device__ __forceinline__ float bflo(unsigned w) { return __uint_as_float(w << 16); }
__device__ __forceinline__ float bfhi(unsigned w) { return __uint_as_float(w & 0xffff0000u); }
__device__ __forceinline__ float wave_sum(float v) {
#pragma unroll
    for (int o = 1; o < 64; o <<= 1) v += __shfl_xor(v, o);
    return v;
}
__device__ __forceinline__ float silu_f(float v) { return v * __builtin_amdgcn_rcpf(1.0f + __expf(-v)); }

template <bool PERM_IN> __device__ __forceinline__ void p0_transpose_item(const float* W, const float* g, int K, int N, bf16* WT, LAS float* scr, int item, int lane) {
    const int nblk = N / 32, kb = item / nblk, nb = item % nblk, k0 = 64 * kb, n0 = 32 * nb;
    int d0 = n0;
    if (PERM_IN && n0 >= 512 && n0 < 1536) { const int ch = (n0 - 512) & 511, hsel = (n0 - 512) >> 9; d0 = 512 + 256 * (ch >> 7) + 128 * hsel + (ch & 127); }
    float wv[32];
#pragma unroll
    for (int i = 0; i < 32; ++i) wv[i] = __builtin_nontemporal_load(W + (size_t)(k0 + 2 * i + (lane >> 5)) * N + n0 + (lane & 31));
    const float gl = g ? g[k0 + lane] : 1.0f;
#pragma unroll
    for (int i = 0; i < 32; ++i) { const int kk = 2 * i + (lane >> 5); scr[kk * 33 + (lane & 31)] = wv[i] * __shfl(gl, kk); }
    asm volatile("s_waitcnt lgkmcnt(0)" ::: "memory");
    const int c = lane & 7;
#pragma unroll
    for (int j = 0; j < 4; ++j) { const int n = (lane >> 3) + 8 * j; const LAS float* s = scr + (8 * c) * 33 + n;
        u32x4 o; o.x = pk2(s[0 * 33], s[1 * 33]); o.y = pk2(s[2 * 33], s[3 * 33]); o.z = pk2(s[4 * 33], s[5 * 33]); o.w = pk2(s[6 * 33], s[7 * 33]);
        *(u32x4*)(WT + (size_t)(d0 + n) * K + k0 + 8 * c) = o; }
    asm volatile("s_waitcnt lgkmcnt(0)" ::: "memory");
}

template <bool PERM_IN> __device__ __forceinline__ void p0_transpose_piece(const float* W, const float* g, int K, int N, bf16* WT, LAS float* scr, int item, int part, int lane) {
    const int nblk = N / 32, kb = item / nblk, nb = item % nblk, k0 = 64 * kb + 8 * part, n0 = 32 * nb;
    int d0 = n0;
    if (PERM_IN && n0 >= 512 && n0 < 1536) { const int ch = (n0 - 512) & 511, hsel = (n0 - 512) >> 9; d0 = 512 + 256 * (ch >> 7) + 128 * hsel + (ch & 127); }
    float wv[4];
#pragma unroll
    for (int i = 0; i < 4; ++i) wv[i] = __builtin_nontemporal_load(W + (size_t)(k0 + 2 * i + (lane >> 5)) * N + n0 + (lane & 31));
#pragma unroll
    for (int i = 0; i < 4; ++i) { const int kk = 2 * i + (lane >> 5); scr[kk * 33 + (lane & 31)] = wv[i] * (g ? g[k0 + kk] : 1.0f); }
    asm volatile("s_waitcnt lgkmcnt(0)" ::: "memory");
    if (lane < 32) { const LAS float* sp = scr + lane;
        u32x4 o; o.x = pk2(sp[0 * 33], sp[1 * 33]); o.y = pk2(sp[2 * 33], sp[3 * 33]); o.z = pk2(sp[4 * 33], sp[5 * 33]); o.w = pk2(sp[6 * 33], sp[7 * 33]);
        *(u32x4*)(WT + (size_t)(d0 + lane) * K + k0) = o; }
    asm volatile("s_waitcnt lgkmcnt(0)" ::: "memory");
}
typedef const __attribute__((address_space(4))) Args* KArgsP;
__device__ __forceinline__ void p0_prologue(KArgsP Ap, LAS unsigned char* lds, int gw, int NGW, int wave, int lane) {
    LAS float* scr = (LAS float*)(lds + wave * 16384);
    constexpr int I_IN = (D / 64) * (NIN / 32), I_SQ = (D / 64) * (D / 32), I_PE = (PLE / 64) * (D / 32), I_L = I_IN + 2 * I_SQ + I_PE;
    const int n_items = DEPTH * I_L, n_whole = (n_items / NGW) * NGW, n_left = n_items - n_whole;
    for (int it = gw; it < n_whole + 8 * n_left; it += NGW) {
        const bool whole = it < n_whole;
        const int item = whole ? it : n_whole + ((it - n_whole) >> 3), part = (it - n_whole) & 7;
        const int l = item / I_L; int r = item % I_L;
        bf16* wt = (bf16*)(Ap->ws + WS_WT + (size_t)l * WT_LAYER);
        if (r < I_IN) { const float* W = Ap->w_in + (size_t)l * D * NIN; const float* g = Ap->norm_g + l * D;
            if (whole) p0_transpose_item<true>(W, g, D, NIN, wt, scr, r, lane); else p0_transpose_piece<true>(W, g, D, NIN, wt, scr, r, part, lane); continue; } r -= I_IN;
        if (r < I_SQ) { const float* W = Ap->w_out + (size_t)l * D * D; bf16* o = (bf16*)((unsigned char*)wt + WT_OUT);
            if (whole) p0_transpose_item<false>(W, nullptr, D, D, o, scr, r, lane); else p0_transpose_piece<false>(W, nullptr, D, D, o, scr, r, part, lane); continue; } r -= I_SQ;
        if (r < I_SQ) { const float* W = Ap->w_pg + (size_t)l * D * D; const float* g = Ap->ple_norm_g + l * D; bf16* o = (bf16*)((unsigned char*)wt + WT_PG);
            if (whole) p0_transpose_item<false>(W, g, D, D, o, scr, r, lane); else p0_transpose_piece<false>(W, g, D, D, o, scr, r, part, lane); continue; } r -= I_SQ;
        { const float* W = Ap->w_pe + (size_t)l * PLE * D; bf16* o = (bf16*)((unsigned char*)wt + WT_PE);
            if (whole) p0_transpose_item<false>(W, nullptr, PLE, D, o, scr, r, lane); else p0_transpose_piece<false>(W, nullptr, PLE, D, o, scr, r, part, lane); }
    }
    float* ss = (float*)(Ap->ws + WS_SS);
    bf16* xb = (bf16*)(Ap->ws + WS_XB);
    for (int m = gw; m < M; m += 2 * NGW) {
        const int m2 = m + NGW;
        const f32x4* xr = (const f32x4*)(Ap->x + (size_t)m * D) + lane; const f32x4* xr2 = (const f32x4*)(Ap->x + (size_t)m2 * D) + lane;
        unsigned long long* o8 = (unsigned long long*)(xb + (size_t)m * D) + lane; unsigned long long* o82 = (unsigned long long*)(xb + (size_t)m2 * D) + lane;
        f32x4 v[4], w[4];
        const bool two = m2 < M;
#pragma unroll
        for (int j = 0; j < 4; ++j) { v[j] = __builtin_nontemporal_load(xr + 64 * j); w[j] = two ? __builtin_nontemporal_load(xr2 + 64 * j) : v[j]; }
        float s = 0.f, s2 = 0.f;
#pragma unroll
        for (int j = 0; j < 4; ++j) {
            s += (v[j].x * v[j].x + v[j].y * v[j].y) + (v[j].z * v[j].z + v[j].w * v[j].w); s2 += (w[j].x * w[j].x + w[j].y * w[j].y) + (w[j].z * w[j].z + w[j].w * w[j].w);
            o8[64 * j] = (unsigned long long)pk2(v[j].x, v[j].y) | ((unsigned long long)pk2(v[j].z, v[j].w) << 32);
            if (two) o82[64 * j] = (unsigned long long)pk2(w[j].x, w[j].y) | ((unsigned long long)pk2(w[j].z, w[j].w) << 32); }
        s = wave_sum(s); s2 = wave_sum(s2);
        if (lane == 0) { ss[m] = s; if (two) ss[m2] = s2; }
    }
    for (int i = gw * 64 + lane; i < 4 * M; i += NGW * 64) ss[M + i] = 0.f;
    bf16* pb = (bf16*)(Ap->ws + WS_PB);
    for (int i = gw * 64 + lane; i < DEPTH * M * PLE / 8; i += 4 * NGW * 64) {
        f32x4 a[4], b[4];
#pragma unroll
        for (int j = 0; j < 4; ++j) { const size_t c = (size_t)i + (size_t)j * NGW * 64; const size_t e = (c < (size_t)(DEPTH * M * PLE / 8) ? c : (size_t)i) * 8; a[j] = __builtin_nontemporal_load((const f32x4*)(Ap->p + e)); b[j] = __builtin_nontemporal_load((const f32x4*)(Ap->p + e + 4)); }
#pragma unroll
        for (int j = 0; j < 4; ++j) { const size_t c = (size_t)i + (size_t)j * NGW * 64; const size_t e = (c < (size_t)(DEPTH * M * PLE / 8) ? c : (size_t)i) * 8;
            u32x4 w; w.x = pk2(a[j].x, a[j].y); w.y = pk2(a[j].z, a[j].w); w.z = pk2(b[j].x, b[j].y); w.w = pk2(b[j].z, b[j].w);
            *(u32x4*)(pb + e) = w; }
    }
}

__device__ __forceinline__ void unpack8(const u32x4 v, float (&f)[8]) {
    f[0] = bflo(v.x); f[1] = bfhi(v.x); f[2] = bflo(v.y); f[3] = bfhi(v.y); f[4] = bflo(v.z); f[5] = bfhi(v.z); f[6] = bflo(v.w); f[7] = bfhi(v.w);
}
typedef float f2 __attribute__((ext_vector_type(2)));
__device__ __forceinline__ void unpack4(const u32x4 v, f2 (&o)[4]) {
    o[0] = (f2){bflo(v.x), bfhi(v.x)}; o[1] = (f2){bflo(v.y), bfhi(v.y)}; o[2] = (f2){bflo(v.z), bfhi(v.z)}; o[3] = (f2){bflo(v.w), bfhi(v.w)};
}
__device__ __forceinline__ void conv_item(const bf16* P, bf16* Y, const float* cw, const float* cb, const float* bg, int item, int lane) {
    const int t0 = item * 8, c0 = lane * 8;
    const bool first = (t0 & (SEQ - 1)) == 0;
    const int tm2 = first ? t0 : t0 - 2, tm1 = first ? t0 : t0 - 1;
    u32x4 ld[8][3];
    const u32x4 h0 = *(const u32x4*)(P + (size_t)tm2 * 4096 + 512 + c0), h1 = *(const u32x4*)(P + (size_t)tm1 * 4096 + 512 + c0);
#pragma unroll
    for (int tt = 0; tt < 8; ++tt) {
        const bf16* pr = P + (size_t)(t0 + tt) * 4096 + c0;
        ld[tt][0] = *(const u32x4*)(pr); ld[tt][1] = *(const u32x4*)(pr + 512); ld[tt][2] = *(const u32x4*)(pr + 1536);
    }
    f2 w0[4], w1[4], w2[4], bb[4], gg[4];
#pragma unroll
    for (int i = 0; i < 4; ++i) { w0[i] = *(const f2*)(cw + c0 + 2 * i); w1[i] = *(const f2*)(cw + 512 + c0 + 2 * i); w2[i] = *(const f2*)(cw + 1024 + c0 + 2 * i);
        bb[i] = *(const f2*)(cb + c0 + 2 * i); gg[i] = *(const f2*)(bg + c0 + 2 * i); }
    f2 u[3][4];
    unpack4(h0, u[0]); unpack4(h1, u[1]);
    if (first) {
#pragma unroll
        for (int i = 0; i < 4; ++i) { u[0][i] = (f2){0.f, 0.f}; u[1][i] = (f2){0.f, 0.f}; }
    }
#pragma unroll
    for (int tt = 0; tt < 8; ++tt) {
        f2 fb[4], fz[4], y[4];
        unpack4(ld[tt][0], fb); unpack4(ld[tt][1], u[(tt + 2) % 3]); unpack4(ld[tt][2], fz);
        f2 sqv = (f2){0.f, 0.f};
#pragma unroll
        for (int i = 0; i < 4; ++i) { y[i] = fb[i] * (bb[i] + w0[i] * u[tt % 3][i] + w1[i] * u[(tt + 1) % 3][i] + w2[i] * u[(tt + 2) % 3][i]); sqv += y[i] * y[i]; }
        float sq = sqv.x + sqv.y;
        sq += __shfl_xor(sq, 1); sq += __shfl_xor(sq, 2); sq += __shfl_xor(sq, 4);
        const float r = rsqrtf(sq * (1.0f / 64.0f) + pg8::RMS_EPS);
        unsigned ow[4];
#pragma unroll
        for (int i = 0; i < 4; ++i) {
            f2 sg; sg.x = __builtin_amdgcn_rcpf(1.0f + __expf(-fz[i].x)); sg.y = __builtin_amdgcn_rcpf(1.0f + __expf(-fz[i].y));
            const f2 o = (y[i] * (gg[i] * r)) * (fz[i] * sg);
            ow[i] = pk2(o.x, o.y);
        }
        u32x4 w; w.x = ow[0]; w.y = ow[1]; w.z = ow[2]; w.w = ow[3];
        *(u32x4*)(Y + (size_t)(t0 + tt) * 1024 + c0) = w;
    }
}

typedef float f32x16 __attribute__((ext_vector_type(16)));
typedef float f32x2_t __attribute__((ext_vector_type(2)));
typedef __bf16 bf16x2_t __attribute__((ext_vector_type(2)));
typedef unsigned u32x2 __attribute__((ext_vector_type(2)));
__device__ __forceinline__ unsigned cvtpk(float lo, float hi) { f32x2_t v = {lo, hi}; bf16x2_t b = __builtin_convertvector(v, bf16x2_t); return __builtin_bit_cast(unsigned, b); }
#define MFMA32(a, b, c) __builtin_amdgcn_mfma_f32_32x32x16_bf16((a), (b), (c), 0, 0, 0)

typedef short v4i16_t __attribute__((ext_vector_type(4)));
template <bool DIAG>
__device__ __forceinline__ void attn_tile(LAS unsigned char* wl, const int krd, const int ksw, const int vrow, const int vch, const int vf0, const int hh, const int r,
                                          const pg8::bf16x8 (&qf)[4], f32x16& o0, f32x16& o1, float& carry2) {
    pg8::bf16x8 kf[4], vf[2][2];
#pragma unroll
    for (int kk = 0; kk < 4; ++kk) kf[kk] = *(const LAS pg8::bf16x8*)(wl + krd + (((2 * kk + hh) ^ ksw) * 16));
#pragma unroll
    for (int mt = 0; mt < 2; ++mt)
#pragma unroll
        for (int s2 = 0; s2 < 2; ++s2) {
            const v4i16_t lo = __builtin_amdgcn_ds_read_tr16_b64_v4i16((LAS v4i16_t*)(wl + vrow + (8 * s2 + 0) * 128 + (((4 * mt + vch) ^ vf0) * 16)));
            const v4i16_t hi = __builtin_amdgcn_ds_read_tr16_b64_v4i16((LAS v4i16_t*)(wl + vrow + (8 * s2 + 4) * 128 + (((4 * mt + vch) ^ vf0 ^ 4) * 16)));
            vf[mt][s2] = (pg8::bf16x8){lo[0], lo[1], lo[2], lo[3], hi[0], hi[1], hi[2], hi[3]};
        }
    f32x16 z;
#pragma unroll
    for (int i = 0; i < 16; ++i) z[i] = 0.f;
#pragma unroll
    for (int kk = 0; kk < 4; ++kk) z = MFMA32(kf[kk], qf[kk], z);
    float om[16], be[16], pre[16], a[16];
#pragma unroll
    for (int i = 0; i < 16; ++i) {
        const float e = __builtin_amdgcn_fmed3f(__builtin_amdgcn_exp2f(-z[i]), 0.0f, 1.0e30f), rc = __builtin_amdgcn_rcpf(1.0f + e);
        be[i] = rc; om[i] = e * rc;
        if (DIAG) { const bool valid = (16 * hh + i) < r; be[i] = valid ? be[i] : 0.f; om[i] = valid ? om[i] : 1.0f; }
    }
    float run = 1.0f;
#pragma unroll
    for (int i = 15; i >= 0; --i) { pre[i] = run; run *= om[i]; }
    const float tot = run, ptot = __shfl_xor(tot, 32);
    const float sh = __builtin_amdgcn_exp2f(carry2) * (hh == 0 ? ptot : 1.0f);
#pragma unroll
    for (int i = 0; i < 16; ++i) a[i] = be[i] * (pre[i] * sh);
    carry2 += __builtin_amdgcn_logf(tot * ptot);
#pragma unroll
    for (int s2 = 0; s2 < 2; ++s2) {
        u32x4 pw; pw.x = cvtpk(a[8 * s2 + 0], a[8 * s2 + 1]); pw.y = cvtpk(a[8 * s2 + 2], a[8 * s2 + 3]); pw.z = cvtpk(a[8 * s2 + 4], a[8 * s2 + 5]); pw.w = cvtpk(a[8 * s2 + 6], a[8 * s2 + 7]);
        const pg8::bf16x8 pf = __builtin_bit_cast(pg8::bf16x8, pw);
        o0 = MFMA32(vf[0][s2], pf, o0);
        o1 = MFMA32(vf[1][s2], pf, o1);
    }
}
__device__ __forceinline__ void attn_item_mfma(const bf16* P, bf16* Y, const float* bg, LAS unsigned char* wl, int item, int lane) {
    const int bh = item >> 7, qt = item & 127, b = bh >> 3, h = bh & 7, q0 = qt * 32;
    const int r = lane & 31, hh = lane >> 5;
    const bf16* base = P + (size_t)b * SEQ * 4096;
    pg8::bf16x8 qf[4];
    u32x4 kA[4], vA[4], kB[4], vB[4];
    {
        const bf16* qp = base + (size_t)(q0 + r) * 4096 + 2048 + h * 64 + hh * 8;
#pragma unroll
        for (int kk = 0; kk < 4; ++kk) qf[kk] = *(const pg8::bf16x8*)(qp + kk * 16);
    }
    const bf16* kg = base + (size_t)(q0 + (lane >> 3)) * 4096 + 2560 + h * 64 + (lane & 7) * 8;
    const int kw = (lane >> 3) * 128 + (((lane & 7) ^ ((lane >> 3) & 7)) * 16);
    const int rw7 = (lane >> 3) & 7;
    const int vw = 4096 + (lane >> 3) * 128 + (((lane & 7) ^ (rw7 ^ (((rw7 >> 1) & 1) << 2))) * 16);
    const int pr = 16 * ((r >> 2) & 1) + (r & 3) + 4 * (r >> 3);
    const int krd = pr * 128, ksw = pr & 7;
    const int tq = (lane & 15) >> 2, tp = lane & 3, tg = (lane >> 4) & 1;
    const int vrow = 4096 + (16 * hh + tq) * 128 + (tp & 1) * 8;
    const int vch = 2 * tg + (tp >> 1);
    const int vf0 = tq ^ (((tq >> 1) & 1) << 2);
#define ATT_LOAD(KR, VR) do { _Pragma("unroll") for (int i = 0; i < 4; ++i) { KR[i] = *(const u32x4*)(kg + (size_t)i * 8 * 4096); VR[i] = *(const u32x4*)(kg + 512 + (size_t)i * 8 * 4096); } } while (0)
#define ATT_STAGE(KR, VR) do { _Pragma("unroll") for (int i = 0; i < 4; ++i) { *(LAS u32x4*)(wl + kw + i * 1024) = KR[i]; *(LAS u32x4*)(wl + vw + i * 1024) = VR[i]; } } while (0)
    ATT_LOAD(kA, vA);
    if (q0 >= 32) { kg -= 32 * 4096; ATT_LOAD(kB, vB); }
    f32x16 o0, o1;
#pragma unroll
    for (int i = 0; i < 16; ++i) { o0[i] = 0.f; o1[i] = 0.f; }
    float carry2 = 0.f;
    ATT_STAGE(kA, vA);
    if (q0 >= 64) { kg -= 32 * 4096; ATT_LOAD(kA, vA); }
    attn_tile<true>(wl, krd, ksw, vrow, vch, vf0, hh, r, qf, o0, o1, carry2);
    if (q0 >= 32) {
        for (int k0 = q0 - 32;;) {
            ATT_STAGE(kB, vB);
            if (k0 >= 64) { kg -= 32 * 4096; ATT_LOAD(kB, vB); }
            attn_tile<false>(wl, krd, ksw, vrow, vch, vf0, hh, r, qf, o0, o1, carry2);
            if (k0 < 32) break;
            if (__all(carry2 < -150.1f)) break;
            k0 -= 32;
            ATT_STAGE(kA, vA);
            if (k0 >= 64) { kg -= 32 * 4096; ATT_LOAD(kA, vA); }
            attn_tile<false>(wl, krd, ksw, vrow, vch, vf0, hh, r, qf, o0, o1, carry2);
            if (k0 < 32) break;
            if (__all(carry2 < -150.1f)) break;
            k0 -= 32;
        }
    }
#undef ATT_LOAD
#undef ATT_STAGE
    float sq = 0.f;
#pragma unroll
    for (int i = 0; i < 16; ++i) sq += o0[i] * o0[i] + o1[i] * o1[i];
    sq += __shfl_xor(sq, 32);
    const float rr = rsqrtf(sq * (1.0f / 64.0f) + pg8::RMS_EPS);
    const size_t row = (size_t)b * SEQ + q0 + r;
#pragma unroll
    for (int mt = 0; mt < 2; ++mt)
#pragma unroll
        for (int g = 0; g < 4; ++g) {
            const int d0 = mt * 32 + 8 * g + 4 * hh;
            const u32x2 zw = *(const u32x2*)(P + row * 4096 + 3584 + h * 64 + d0);
            const f32x4 gg = *(const f32x4*)(bg + 512 + h * 64 + d0);
            float y[4];
#pragma unroll
            for (int j = 0; j < 4; ++j) { const float ov = mt == 0 ? o0[4 * g + j] : o1[4 * g + j]; y[j] = ov * rr * gg[j]; }
            y[0] *= silu_f(bflo(zw.x)); y[1] *= silu_f(bfhi(zw.x)); y[2] *= silu_f(bflo(zw.y)); y[3] *= silu_f(bfhi(zw.y));
            u32x2 ow; ow.x = cvtpk(y[0], y[1]); ow.y = cvtpk(y[2], y[3]);
            *(u32x2*)(Y + row * 1024 + 512 + h * 64 + d0) = ow;
        }
}

#define XB_TMO      128
#define XB_XCNT(j)  (256  + 64 * (j))
#define XB_XSUB(j)  (1280 + 64 * (j))
#define XB_XGEN(j)  (2304 + 64 * (j))
#define XB_TOP      3328
#define XB_TOPGEN   3392
#define XCD_BAR_WORDS 3456
#define XB_SPIN_CAP (1u << 18)

__device__ __forceinline__ unsigned xb_ld(unsigned* p)              { return __hip_atomic_load(p, __ATOMIC_RELAXED, __HIP_MEMORY_SCOPE_AGENT); }
__device__ __forceinline__ unsigned xb_add(unsigned* p, unsigned v) { return __hip_atomic_fetch_add(p, v, __ATOMIC_RELAXED, __HIP_MEMORY_SCOPE_AGENT); }
__device__ __forceinline__ unsigned xb_xcc_id() { return (unsigned)__builtin_amdgcn_s_getreg((3 << 11) | 20) & 0xFu; }
#define XB_SPIN(cond, bar) do { unsigned _sp = 0; while (cond) { __builtin_amdgcn_s_sleep(1); \
    if ((++_sp & 255u) == 0u) { if (xb_ld(&(bar)[XB_TMO])) break; if (_sp > XB_SPIN_CAP) { atomicAdd(&(bar)[XB_TMO], 1u); break; } } } } while (0)

struct XcdBarrier {
    unsigned* bar; unsigned x;
    volatile LAS unsigned* st;
};

__device__ __forceinline__ XcdBarrier xcd_barrier_post(unsigned* bar, volatile LAS unsigned* st) {
    XcdBarrier b; b.bar = bar; b.x = xb_xcc_id(); b.st = st;
    if (threadIdx.x == 0) (void)xb_add(&bar[XB_XCNT(b.x)], 1u);
    return b;
}
__device__ __forceinline__ void xcd_barrier_complete(unsigned* bar, unsigned x, unsigned& nloc, unsigned& nx) {
    const unsigned G = gridDim.x * gridDim.y * gridDim.z;
    unsigned sum, cnt, mine, sp = 0u;
    for (;;) {
        sum = 0u; cnt = 0u; mine = 0u;
#pragma unroll
        for (unsigned j = 0; j < 16; ++j) { const unsigned c = xb_ld(&bar[XB_XCNT(j)]); sum += c; cnt += (c > 0u) ? 1u : 0u; mine = (j == x) ? c : mine; }
        if (sum == G) break;
        __builtin_amdgcn_s_sleep(1);
        if ((++sp & 255u) == 0u) { if (xb_ld(&bar[XB_TMO])) break; if (sp > XB_SPIN_CAP) { atomicAdd(&bar[XB_TMO], 1u); break; } }
    }
    nloc = mine > 0u ? mine : 1u; nx = cnt > 0u ? cnt : 1u;
}

__device__ __forceinline__ void xcd_barrier(const XcdBarrier& b) {
    asm volatile("s_waitcnt vmcnt(0)" ::: "memory");
    __syncthreads();
    if (threadIdx.x == 0) {
        unsigned* bar = b.bar;
        __builtin_amdgcn_s_waitcnt(0);
        unsigned nloc = b.st[0], nx = b.st[1];
        if (nloc == 0u) { xcd_barrier_complete(bar, b.x, nloc, nx); b.st[0] = nloc; b.st[1] = nx; }
        const unsigned old = xb_add(&bar[XB_XSUB(b.x)], 1u);
        const unsigned gen = old / nloc;
        if (old + 1u == (gen + 1u) * nloc) {
            __builtin_amdgcn_fence(__ATOMIC_RELEASE, "agent");
            asm volatile("s_waitcnt vmcnt(0)" ::: "memory");
            const unsigned og = xb_add(&bar[XB_TOP], 1u);
            const unsigned tg = og / nx;
            if (og + 1u == (tg + 1u) * nx) xb_add(&bar[XB_TOPGEN], 1u);
            else XB_SPIN(xb_ld(&bar[XB_TOPGEN]) == tg, bar);
            __builtin_amdgcn_fence(__ATOMIC_ACQUIRE, "agent");
            xb_add(&bar[XB_XGEN(b.x)], 1u);
            asm volatile("s_waitcnt vmcnt(0)" ::: "memory");
        } else {
            XB_SPIN(xb_ld(&bar[XB_XGEN(b.x)]) == gen, bar);
            __builtin_amdgcn_fence(__ATOMIC_ACQUIRE, "agent");
            asm volatile("s_waitcnt vmcnt(0)" ::: "memory");
        }
    }
    __syncthreads();
}


typedef const __attribute__((address_space(4))) Args* KArgs;
__device__ __forceinline__ KArgs kargs() { KArgs p = (KArgs)__builtin_amdgcn_kernarg_segment_ptr(); asm volatile("" : "+s"(p)); return p; }
__device__ __forceinline__ int opaque_tid() { int t = threadIdx.x; asm volatile("" : "+v"(t)); return t; }

__global__ void __launch_bounds__(NTHREADS, 2) sb_fwd(Args A_unused) {
    extern __shared__ __attribute__((aligned(16))) unsigned char lds_raw[];
    cg::grid_group grid = cg::this_grid();
    LAS unsigned char* lds = (LAS unsigned char*)lds_raw;
    if (gridDim.y == 0x7fffu) grid.sync();
    volatile LAS unsigned* bst = (volatile LAS unsigned*)(lds + 131072);
    if (threadIdx.x < 16) bst[threadIdx.x] = 0u;
    __syncthreads();
    XcdBarrier bar;
    { KArgs ka = kargs(); bar = xcd_barrier_post((unsigned*)(ka->ws + WS_BAR), bst); }

    {
        KArgs ka = kargs(); const int tid = opaque_tid(), lane = tid & 63, wave = __builtin_amdgcn_readfirstlane(tid >> 6);
        const int G = gridDim.x, gw = blockIdx.x * NWAVES + wave, NGW = G * NWAVES;
        p0_prologue(ka, lds, gw, NGW, wave, lane);
    }
    GRID_SYNC();

#pragma unroll 1
    for (int l = 0; l < DEPTH; ++l) {
        {
            KArgs ka = kargs(); unsigned char* ws = ka->ws; const int G = gridDim.x;
            pg8::Gemm g{(const bf16*)(ws + (l == 0 ? WS_XB : WS_XB2)), (const bf16*)(ws + WS_WT + (size_t)l * WT_LAYER), M, NIN, D};
            pg8::StaticOrder S; S.init(M, NIN, G, (int)blockIdx.x);
            const float* ssl = (const float*)(ws + WS_SS) + (size_t)(2 * l) * M;
            LAS float* rtab = (LAS float*)(lds + 131072 + 64);
            pg8::Unit u0; int pm0 = -1;
            if (S.next(0, u0)) { pm0 = u0.pm; const int t = opaque_tid(); if (t < 256) rtab[t] = rsqrtf(ssl[pm0 * 256 + t] * (1.0f / 1024.0f) + pg8::RMS_EPS); }
            __syncthreads();
            pg8::EpiProj E{(bf16*)(ws + WS_PROJ), ssl, rtab, pm0};
            pg8::gemm_phase<pg8::EpiProj, pg8::StaticOrder, true, true>(lds, g, S, E);
        }
        GRID_SYNC();
        {
            KArgs ka = kargs(); unsigned char* ws = ka->ws; const int tid = opaque_tid(), lane = tid & 63, wave = __builtin_amdgcn_readfirstlane(tid >> 6);
            const int G = gridDim.x, gw = blockIdx.x * NWAVES + wave, NGW = G * NWAVES;
            const bf16* PROJ = (const bf16*)(ws + WS_PROJ); bf16* Y = (bf16*)ka->out;
            const float* cw = ka->conv_w + (size_t)l * 3 * 512; const float* cb = ka->conv_b + (size_t)l * 512; const float* bg = ka->branch_g + (size_t)l * 1024;
            const bool conv_first = false;
            const bool loc = (G == 256);
            if (conv_first) for (int it = gw; it < M / 8; it += NGW) conv_item(PROJ, Y, cw, cb, bg, loc ? 256 * ((it >> 3) & 7) + ((it >> 6) << 3) + (it & 7) : it, lane);
            for (int it = gw; it < 32 * 128; it += NGW) {
                int item = it;
                if (loc) { const int xcd = (it >> 3) & 7, j = (((it & 2047) >> 6) << 3) + (it & 7) + 256 * (it >> 11);
                    item = ((((xcd >> 1) * 8) + (j >> 6)) << 7) | ((xcd & 1) * 64 + (j & 63)); }
                attn_item_mfma(PROJ, Y, bg, lds + wave * 8192, item, lane);
            }
            if (!conv_first) for (int it = gw; it < M / 8; it += NGW) conv_item(PROJ, Y, cw, cb, bg, loc ? 256 * ((it >> 3) & 7) + ((it >> 6) << 3) + (it & 7) : it, lane);
        }
        GRID_SYNC();
        {
            KArgs ka = kargs(); unsigned char* ws = ka->ws; const int G = gridDim.x;
            pg8::Gemm g{(const bf16*)ka->out, (const bf16*)(ws + WS_WT + (size_t)l * WT_LAYER + WT_OUT), M, D, D};
            pg8::StaticOrder S; S.init(M, D, G, (int)blockIdx.x);
            float* ssn = (float*)(ws + WS_SS) + (size_t)(2 * l + 1) * M;
            if (l == 0) { pg8::EpiOut<false> E{ka->x, nullptr, (bf16*)(ws + WS_XB), ssn}; pg8::gemm_phase<pg8::EpiOut<false>, pg8::StaticOrder, true, true>(lds, g, S, E); }
            else        { pg8::EpiOut<true> E{nullptr, (const bf16*)(ws + WS_XB2), (bf16*)(ws + WS_XB), ssn}; pg8::gemm_phase<pg8::EpiOut<true>, pg8::StaticOrder, true, true>(lds, g, S, E); }
        }
        {
            KArgs ka = kargs(); unsigned char* ws = ka->ws; const int G = gridDim.x;
            pg8::Gemm g2{(const bf16*)(ws + WS_PB) + (size_t)l * M * PLE, (const bf16*)(ws + WS_WT + (size_t)l * WT_LAYER + WT_PE), M, D, PLE};
            pg8::StaticOrder S; S.init(M, D, G, (int)blockIdx.x);
            pg8::EpiPlain E2{(bf16*)(ws + WS_PROJ), D};
            pg8::gemm_phase<pg8::EpiPlain, pg8::StaticOrder, true, true>(lds, g2, S, E2);
        }
        GRID_SYNC();
        {
            KArgs ka = kargs(); unsigned char* ws = ka->ws; const int G = gridDim.x;
            pg8::Gemm g{(const bf16*)(ws + WS_XB), (const bf16*)(ws + WS_WT + (size_t)l * WT_LAYER + WT_PG), M, D, D};
            pg8::StaticOrder S; S.init(M, D, G, (int)blockIdx.x);
            float* SS = (float*)(ws + WS_SS);
            pg8::EpiPg E{(const bf16*)(ws + WS_XB), (float*)nullptr, (bf16*)(ws + WS_XB2), SS + (size_t)(2 * l + 1) * M, SS + (size_t)(2 * l + 2) * M, ka->b_pg + (size_t)l * D, (const bf16*)(ws + WS_PROJ)};
            pg8::gemm_phase<pg8::EpiPg, pg8::StaticOrder, true, true>(lds, g, S, E);
        }
        GRID_SYNC();
    }
    {
        KArgs ka = kargs(); const int tid = opaque_tid(), lane = tid & 63, wave = __builtin_amdgcn_readfirstlane(tid >> 6);
        const int G = gridDim.x, gw = blockIdx.x * NWAVES + wave, NGW = G * NWAVES;
        const float* ssf = (const float*)(ka->ws + WS_SS) + (size_t)(2 * DEPTH) * M;
        const bf16* xs = (const bf16*)(ka->ws + WS_XB2);
        float* out = ka->out;
        f32x4 gv[4];
#pragma unroll
        for (int j = 0; j < 4; ++j) gv[j] = ((const f32x4*)ka->final_g)[4 * lane + j];
        for (int m = gw; m < M; m += 4 * NGW) {
            u32x4 w[4][2]; float r[4];
#pragma unroll
            for (int q = 0; q < 4; ++q) { const int mq = (m + q * NGW < M) ? m + q * NGW : m;
                const u32x4* xr = (const u32x4*)(xs + (size_t)mq * D) + 2 * lane; w[q][0] = xr[0]; w[q][1] = xr[1];
                r[q] = rsqrtf(ssf[mq] * (1.0f / 1024.0f) + pg8::RMS_EPS); }
#pragma unroll
            for (int q = 0; q < 4; ++q) { if (m + q * NGW < M) {
                f32x4* o = (f32x4*)(out + (size_t)(m + q * NGW) * D) + 4 * lane;
                const u32x4 a = w[q][0], b = w[q][1];
                o[0] = (f32x4){bflo(a.x), bfhi(a.x), bflo(a.y), bfhi(a.y)} * r[q] * gv[0];
                o[1] = (f32x4){bflo(a.z), bfhi(a.z), bflo(a.w), bfhi(a.w)} * r[q] * gv[1];
                o[2] = (f32x4){bflo(b.x), bfhi(b.x), bflo(b.y), bfhi(b.y)} * r[q] * gv[2];
                o[3] = (f32x4){bflo(b.z), bfhi(b.z), bflo(b.w), bfhi(b.w)} * r[q] * gv[3]; } }
        }
    }
}

extern "C" void kernel_launch(void* const* d_in, const int* in_sizes, int n_in, void* d_out, int out_size, void* d_ws, size_t ws_size, hipStream_t stream) {
    static int grid = 0;
    if (grid == 0) {
        if (n_in != 13 || in_sizes[0] != M * D || out_size != M * D || ws_size < WS_END) { fprintf(stderr, "kernel_launch: unexpected shapes / workspace (%d inputs, ws %zu)\n", n_in, ws_size); grid = -1; return; }
        int dev = 0, cus = 0, per_cu = 0;
        if (hipGetDevice(&dev) != hipSuccess || hipDeviceGetAttribute(&cus, hipDeviceAttributeMultiprocessorCount, dev) != hipSuccess) { grid = -1; return; }
        if (hipFuncSetAttribute((const void*)sb_fwd, hipFuncAttributeMaxDynamicSharedMemorySize, LDS_BYTES) != hipSuccess) { fprintf(stderr, "kernel_launch: hipFuncSetAttribute failed\n"); grid = -1; return; }
        if (hipOccupancyMaxActiveBlocksPerMultiprocessor(&per_cu, (const void*)sb_fwd, NTHREADS, LDS_BYTES) != hipSuccess || per_cu < 1) { fprintf(stderr, "kernel_launch: occupancy query gave %d\n", per_cu); (void)hipGetLastError(); grid = -1; return; }
        grid = cus * per_cu;
    }
    if (grid < 0) return;
    if (hipMemsetAsync((char*)d_ws + WS_BAR, 0, WS_BAR_BYTES, stream) != hipSuccess) { fprintf(stderr, "kernel_launch: memset of the barrier words failed\n"); return; }
    Args a{};
    a.x = (const float*)d_in[0]; a.p = (const float*)d_in[1]; a.norm_g = (const float*)d_in[2]; a.w_in = (const float*)d_in[3]; a.conv_w = (const float*)d_in[4];
    a.conv_b = (const float*)d_in[5]; a.branch_g = (const float*)d_in[6]; a.w_out = (const float*)d_in[7]; a.ple_norm_g = (const float*)d_in[8]; a.w_pg = (const float*)d_in[9];
    a.b_pg = (const float*)d_in[10]; a.w_pe = (const float*)d_in[11]; a.final_g = (const float*)d_in[12];
    a.out = (float*)d_out; a.ws = (unsigned char*)d_ws;
    void* args[] = {&a};
    hipError_t e = hipLaunchCooperativeKernel((const void*)sb_fwd, dim3(grid), dim3(NTHREADS), args, LDS_BYTES, stream);
    if (e != hipSuccess) fprintf(stderr, "kernel_launch: cooperative launch failed: %s (grid %d)\n", hipGetErrorString(e), grid);
}
```

```cpp
#include <hip/hip_runtime.h>
#include <hip/hip_cooperative_groups.h>
#include <cstdio>
#include <cstdint>
#define GRID_SYNC() xcd_barrier(bar)
namespace cg = cooperative_groups;
namespace pg8 {
#define PG8_LAS __attribute__((address_space(3)))
typedef unsigned short bf16_t;
typedef short bf16x8 __attribute__((ext_vector_type(8)));
typedef float f32x4 __attribute__((ext_vector_type(4)));
typedef unsigned u32x4 __attribute__((ext_vector_type(4)));
constexpr int BM = 256, BK = 64, HALF = 128, HTB = HALF * BK * 2  , STAGE_BYTES = 8 * HTB, NXCD = 8, WGM = 8;

__host__ __device__ __forceinline__ int lds_byte(int r, int c) { const int st = (r >> 4) * 2 + (c >> 5), rr = r & 15, cc = c & 31, ob = rr * 64 + cc * 2; return st * 1024 + (ob ^ (((ob >> 9) & 1) << 5)); }
__host__ __device__ __forceinline__ void stage_rc(int b, int& R, int& C) { const int st = b / 1024, sb = b % 1024, swz = sb ^ (((sb >> 9) & 1) << 5); R = (st >> 1) * 16 + swz / 64; C = (st & 1) * 32 + (swz % 64) / 2; }
__host__ __device__ __forceinline__ int perm32(int rho) { const int n = rho >> 4, i = rho & 15; return 8 * (i >> 2) + 4 * n + (i & 3); }

struct Unit { int pm, pn; };
struct Gemm { const bf16_t* A; const bf16_t* Bt; int M, N, K; };

struct StaticOrder {
    int nM, nN, nwg, G, c;
    __host__ __device__ void init(int M, int N, int G_, int c_) { nM = M / BM; nN = N / BM; nwg = nM * nN; G = G_; c = c_; }
    __host__ __device__ bool next(int i, Unit& u) const {
        const long L = (long)i * G + c; if (L >= nwg) return false;
        int wgid = (int)L; { const int q = nwg / NXCD, r = nwg % NXCD, xcd = wgid % NXCD, off = wgid / NXCD; wgid = (xcd < r ? xcd * (q + 1) : r * (q + 1) + (xcd - r) * q) + off; }
        const int nig = WGM * nN, gid = wgid / nig, fm = gid * WGM, gsz = (nM - fm) < WGM ? (nM - fm) : WGM;
        u.pm = fm + ((wgid % nig) % gsz); u.pn = (wgid % nig) / gsz; return true;
    }
    __device__ __forceinline__ void a_ready(const Unit&) const {}
    __device__ __forceinline__ void done(const Unit&) const {}
};
__device__ __forceinline__ unsigned cvt_pk_bf16(float lo, float hi) { unsigned r; asm volatile("v_cvt_pk_bf16_f32 %0, %1, %2" : "=v"(r) : "v"(lo), "v"(hi)); return r; }
__device__ __forceinline__ float bf_lo(unsigned w) { return __uint_as_float(w << 16); }
__device__ __forceinline__ float bf_hi(unsigned w) { return __uint_as_float(w & 0xffff0000u); }
constexpr float RMS_EPS = 1e-6f;

struct EpiProj {
    static constexpr bool PERM = true, AFTER_DRAIN = false;
    bf16_t* P; const float* ss; const PG8_LAS float* rtab; int pm0;
    __device__ __forceinline__ void operator()(const f32x4 (&acc)[2][2][4][2], const Unit& u, int wr, int wc, int fr, int fq) const {
        const int colb = u.pn * BM + wc * 32 + 8 * fq;
        const float qs = (u.pn == 8 || u.pn == 9) ? 0.18033688011112042f : 1.0f;
        const bool isu = (u.pn >= 2 && u.pn <= 5);
#pragma unroll
        for (int ai = 0; ai < 2; ++ai)
#pragma unroll
            for (int m = 0; m < 4; ++m) {
                const int row = u.pm * BM + ai * HALF + wr * 64 + m * 16 + fr;
                const float r = (u.pm == pm0 ? rtab[ai * HALF + wr * 64 + m * 16 + fr] : rsqrtf(ss[row] * (1.0f / 1024.0f) + RMS_EPS)) * qs;
                if (isu) {
                    const f32x4 v0 = (acc[ai][0][m][0] * r) * (acc[ai][1][m][0] * r), v1 = (acc[ai][0][m][1] * r) * (acc[ai][1][m][1] * r);
                    u32x4 w; w.x = cvt_pk_bf16(v0[0], v0[1]); w.y = cvt_pk_bf16(v0[2], v0[3]); w.z = cvt_pk_bf16(v1[0], v1[1]); w.w = cvt_pk_bf16(v1[2], v1[3]);
                    *(u32x4*)(P + (size_t)row * 4096 + 512 + 128 * (u.pn - 2) + wc * 32 + 8 * fq) = w;
                } else {
#pragma unroll
                for (int bj = 0; bj < 2; ++bj) {
                    const int col = colb + bj * HALF;
                    const f32x4 v0 = acc[ai][bj][m][0] * r, v1 = acc[ai][bj][m][1] * r;
                    u32x4 w; w.x = cvt_pk_bf16(v0[0], v0[1]); w.y = cvt_pk_bf16(v0[2], v0[3]); w.z = cvt_pk_bf16(v1[0], v1[1]); w.w = cvt_pk_bf16(v1[2], v1[3]);
                    *(u32x4*)(P + (size_t)row * 4096 + col) = w;
                }
                }
            }
    }
};
struct EpiPlain {
    static constexpr bool PERM = true, AFTER_DRAIN = false;
    bf16_t* O; int ldc;
    __device__ __forceinline__ void operator()(const f32x4 (&acc)[2][2][4][2], const Unit& u, int wr, int wc, int fr, int fq) const {
        const int colb = u.pn * BM + wc * 32 + 8 * fq;
#pragma unroll
        for (int ai = 0; ai < 2; ++ai)
#pragma unroll
            for (int m = 0; m < 4; ++m) {
                const int row = u.pm * BM + ai * HALF + wr * 64 + m * 16 + fr;
#pragma unroll
                for (int bj = 0; bj < 2; ++bj) {
                    const int col = colb + bj * HALF;
                    const f32x4 v0 = acc[ai][bj][m][0], v1 = acc[ai][bj][m][1];
                    u32x4 w; w.x = cvt_pk_bf16(v0[0], v0[1]); w.y = cvt_pk_bf16(v0[2], v0[3]); w.z = cvt_pk_bf16(v1[0], v1[1]); w.w = cvt_pk_bf16(v1[2], v1[3]);
                    *(u32x4*)(O + (size_t)row * ldc + col) = w;
                }
            }
    }
};
template <bool XBF> struct EpiOut {
    static constexpr bool PERM = true, AFTER_DRAIN = false;
    const float* xin; const bf16_t* xinb; bf16_t* xb; float* ssn;
    __device__ __forceinline__ void operator()(const f32x4 (&acc)[2][2][4][2], const Unit& u, int wr, int wc, int fr, int fq) const {
        const int colb = u.pn * BM + wc * 32 + 8 * fq;
        float sq[2][4];
#pragma unroll
        for (int ai = 0; ai < 2; ++ai) {
            const int row0 = u.pm * BM + ai * HALF + wr * 64 + fr;
            f32x4 xa[4][2][2];
            if constexpr (XBF) {
                u32x4 xw[4][2];
#pragma unroll
                for (int m = 0; m < 4; ++m)
#pragma unroll
                    for (int bj = 0; bj < 2; ++bj) xw[m][bj] = __builtin_nontemporal_load((const u32x4*)(xinb + (size_t)(row0 + m * 16) * 1024 + colb + bj * HALF));
#pragma unroll
                for (int m = 0; m < 4; ++m)
#pragma unroll
                    for (int bj = 0; bj < 2; ++bj) { const u32x4 q = xw[m][bj];
                        xa[m][bj][0] = (f32x4){bf_lo(q.x), bf_hi(q.x), bf_lo(q.y), bf_hi(q.y)}; xa[m][bj][1] = (f32x4){bf_lo(q.z), bf_hi(q.z), bf_lo(q.w), bf_hi(q.w)}; }
            } else {
#pragma unroll
                for (int m = 0; m < 4; ++m)
#pragma unroll
                    for (int bj = 0; bj < 2; ++bj) { const size_t off = (size_t)(row0 + m * 16) * 1024 + colb + bj * HALF;
                        xa[m][bj][0] = __builtin_nontemporal_load((const f32x4*)(xin + off)); xa[m][bj][1] = __builtin_nontemporal_load((const f32x4*)(xin + off + 4)); }
            }
#pragma unroll
            for (int m = 0; m < 4; ++m) {
                float q = 0.f;
#pragma unroll
                for (int bj = 0; bj < 2; ++bj) {
                    const size_t off = (size_t)(row0 + m * 16) * 1024 + colb + bj * HALF;
                    const f32x4 v0 = acc[ai][bj][m][0] + xa[m][bj][0], v1 = acc[ai][bj][m][1] + xa[m][bj][1];
                    u32x4 w; w.x = cvt_pk_bf16(v0[0], v0[1]); w.y = cvt_pk_bf16(v0[2], v0[3]); w.z = cvt_pk_bf16(v1[0], v1[1]); w.w = cvt_pk_bf16(v1[2], v1[3]);
                    *(u32x4*)(xb + off) = w;
                    q += (v0[0] * v0[0] + v0[1] * v0[1]) + (v0[2] * v0[2] + v0[3] * v0[3]) + (v1[0] * v1[0] + v1[1] * v1[1]) + (v1[2] * v1[2] + v1[3] * v1[3]);
                }
                sq[ai][m] = q;
            }
        }
#pragma unroll
        for (int ai = 0; ai < 2; ++ai)
#pragma unroll
            for (int m = 0; m < 4; ++m) {
                float q = sq[ai][m]; q += __shfl_xor(q, 16); q += __shfl_xor(q, 32);
                if (fq == 0) atomicAdd(ssn + (u.pm * BM + ai * HALF + wr * 64 + m * 16 + fr), q);
            }
    }
};
struct EpiPg {
    static constexpr bool PERM = true, AFTER_DRAIN = false;
    const bf16_t* xin; float* xout; bf16_t* xb; const float* ss; float* ssn; const float* bias; const bf16_t* pe;
    __device__ __forceinline__ void operator()(const f32x4 (&acc)[2][2][4][2], const Unit& u, int wr, int wc, int fr, int fq) const {
        const int colb = u.pn * BM + wc * 32 + 8 * fq;
        f32x4 bv[2][2];
#pragma unroll
        for (int bj = 0; bj < 2; ++bj) { bv[bj][0] = *(const f32x4*)(bias + colb + bj * HALF); bv[bj][1] = *(const f32x4*)(bias + colb + bj * HALF + 4); }
        float rs[2][4], sq[2][4];
#pragma unroll
        for (int ai = 0; ai < 2; ++ai)
#pragma unroll
            for (int m = 0; m < 4; ++m) rs[ai][m] = ss[u.pm * BM + ai * HALF + wr * 64 + m * 16 + fr];
#pragma unroll
        for (int ai = 0; ai < 2; ++ai)
#pragma unroll
            for (int mp = 0; mp < 2; ++mp) {
                const int row0 = u.pm * BM + ai * HALF + wr * 64 + fr;
                u32x4 xw[2][2], pw[2][2];
#pragma unroll
                for (int mm = 0; mm < 2; ++mm)
#pragma unroll
                    for (int bj = 0; bj < 2; ++bj) { const size_t off = (size_t)(row0 + (2 * mp + mm) * 16) * 1024 + colb + bj * HALF;
                        xw[mm][bj] = *(const u32x4*)(xin + off); pw[mm][bj] = *(const u32x4*)(pe + off); }
#pragma unroll
                for (int mm = 0; mm < 2; ++mm) {
                    const int m = 2 * mp + mm;
                    const float r = rsqrtf(rs[ai][m] * (1.0f / 1024.0f) + RMS_EPS);
                    float q = 0.f;
#pragma unroll
                    for (int bj = 0; bj < 2; ++bj) {
                        const size_t off = (size_t)(row0 + m * 16) * 1024 + colb + bj * HALF;
                        const f32x4 t0 = acc[ai][bj][m][0] * r + bv[bj][0], t1 = acc[ai][bj][m][1] * r + bv[bj][1];
                        f32x4 g0, g1;
#pragma unroll
                        for (int e = 0; e < 4; ++e) { g0[e] = __builtin_amdgcn_rcpf(1.0f + __expf(-t0[e])); g1[e] = __builtin_amdgcn_rcpf(1.0f + __expf(-t1[e])); }
                        const u32x4 pq = pw[mm][bj];
                        const f32x4 p0 = (f32x4){bf_lo(pq.x), bf_hi(pq.x), bf_lo(pq.y), bf_hi(pq.y)}, p1 = (f32x4){bf_lo(pq.z), bf_hi(pq.z), bf_lo(pq.w), bf_hi(pq.w)};
                        const u32x4 xq = xw[mm][bj];
                        const f32x4 x0 = (f32x4){bf_lo(xq.x), bf_hi(xq.x), bf_lo(xq.y), bf_hi(xq.y)}, x1 = (f32x4){bf_lo(xq.z), bf_hi(xq.z), bf_lo(xq.w), bf_hi(xq.w)};
                        const f32x4 v0 = x0 + g0 * p0, v1 = x1 + g1 * p1;
                        if (xout) { *(f32x4*)(xout + off) = v0; *(f32x4*)(xout + off + 4) = v1; }
                        if (xb) { u32x4 w; w.x = cvt_pk_bf16(v0[0], v0[1]); w.y = cvt_pk_bf16(v0[2], v0[3]); w.z = cvt_pk_bf16(v1[0], v1[1]); w.w = cvt_pk_bf16(v1[2], v1[3]);
                            *(u32x4*)(xb + off) = w; }
                        q += (v0[0] * v0[0] + v0[1] * v0[1]) + (v0[2] * v0[2] + v0[3] * v0[3]) + (v1[0] * v1[0] + v1[1] * v1[1]) + (v1[2] * v1[2] + v1[3] * v1[3]);
                    }
                    sq[ai][m] = q;
                }
            }
#pragma unroll
        for (int ai = 0; ai < 2; ++ai)
#pragma unroll
            for (int m = 0; m < 4; ++m) {
                float q = sq[ai][m]; q += __shfl_xor(q, 16); q += __shfl_xor(q, 32);
                if (fq == 0) atomicAdd(ssn + (u.pm * BM + ai * HALF + wr * 64 + m * 16 + fr), q);
            }
    }
};

template <class Epi, class Sched, bool ALIGN_EPI = false, bool SP2 = false>
__device__ __forceinline__ void gemm_phase(PG8_LAS unsigned char* lds, const Gemm g, const Sched& S, const Epi& E) {
    int tid_ = threadIdx.x; asm volatile("" : "+v"(tid_));
    const int tid = tid_, wid = __builtin_amdgcn_readfirstlane(tid >> 6), lane = tid & 63, wr = wid >> 2, wc = wid & 3, fr = lane & 15, fq = lane >> 4;
    int K = g.K; asm volatile("" : "+s"(K)); const int nt = K / BK;
    unsigned voffA[2], voffB[2];
#pragma unroll
    for (int i = 0; i < 2; ++i) { int R, C; stage_rc(tid * 16 + i * 8192, R, C); const int Rb = Epi::PERM ? ((R & ~31) + perm32(R & 31)) : R;
        voffA[i] = (unsigned)(R * K + C) * 2u; voffB[i] = (unsigned)(Rb * K + C) * 2u; }
    const size_t kstep = (size_t)(BK * 2);
    const size_t hstep = (size_t)HALF * K * 2;
    const size_t tstep = 2 * hstep;
    const unsigned ldsw = (unsigned)wid * 1024u;
    const int aoff = lds_byte(wr * 64 + fr, fq * 8), boff = lds_byte(wc * 32 + fr, fq * 8);
#define PG8_SA(b, h) (((b) * 2 + (h)) * HTB)
#define PG8_SB(b, h) ((4 + (b) * 2 + (h)) * HTB)
#define PG8_STAGE(bufoff, gbase, voff) do { _Pragma("unroll") for (int _i = 0; _i < 2; ++_i) \
        __builtin_amdgcn_global_load_lds((const unsigned*)((const char*)(gbase) + (voff)[_i]), (PG8_LAS unsigned*)(lds + (bufoff) + ldsw + _i * 8192), 16, 0, 0); } while (0)
#define PG8_LDA(dst, b, h) do { _Pragma("unroll") for (int m = 0; m < 4; ++m) _Pragma("unroll") for (int k = 0; k < 2; ++k) dst[m][k] = *(const PG8_LAS bf16x8*)(lds + PG8_SA(b, h) + aoff + m * 2048 + k * 1024); } while (0)
#define PG8_LDB(dst, b, h) do { _Pragma("unroll") for (int n = 0; n < 2; ++n) _Pragma("unroll") for (int k = 0; k < 2; ++k) dst[n][k] = *(const PG8_LAS bf16x8*)(lds + PG8_SB(b, h) + boff + n * 2048 + k * 1024); } while (0)
#define PG8_MMA(ai, bj, At, Bt) do { __builtin_amdgcn_s_setprio(1); _Pragma("unroll") for (int m = 0; m < 4; ++m) _Pragma("unroll") for (int n = 0; n < 2; ++n) _Pragma("unroll") for (int k = 0; k < 2; ++k) \
        acc[ai][bj][m][n] = __builtin_amdgcn_mfma_f32_16x16x32_bf16(Bt[n][k], At[m][k], acc[ai][bj][m][n], 0, 0, 0); __builtin_amdgcn_s_setprio(0); } while (0)
#define PG8_WAIT_V(n) asm volatile("s_waitcnt vmcnt(" #n ")" ::: "memory")
#define PG8_WAIT_L(n) asm volatile("s_waitcnt lgkmcnt(" #n ")" ::: "memory")
#define PG8_BAR __builtin_amdgcn_s_barrier()
#define PG8_SCHED __builtin_amdgcn_sched_barrier(0)
    Unit cur, nxt; int ui = 0;
    if (!S.next(0, cur)) return;
    f32x4 acc[2][2][4][2];
#pragma unroll
    for (int a = 0; a < 2; ++a)
#pragma unroll
        for (int b = 0; b < 2; ++b)
#pragma unroll
            for (int m = 0; m < 4; ++m)
#pragma unroll
                for (int n = 0; n < 2; ++n) acc[a][b][m][n] = (f32x4){0.f, 0.f, 0.f, 0.f};
    bf16x8 At[4][2], B0[2][2], B1[2][2];
    const char* cA = (const char*)g.A + (size_t)cur.pm * tstep; const char* cB = (const char*)g.Bt + (size_t)cur.pn * tstep;
    S.a_ready(cur);
    if constexpr (SP2) {
        PG8_STAGE(PG8_SB(0, 0), cB, voffB); PG8_STAGE(PG8_SB(0, 1), cB + hstep, voffB); PG8_STAGE(PG8_SA(0, 0), cA, voffA); PG8_STAGE(PG8_SA(0, 1), cA + hstep, voffA);
        if (wr == 1) PG8_BAR;
        PG8_WAIT_V(2); PG8_BAR;
        PG8_STAGE(PG8_SB(1, 0), cB + kstep, voffB); PG8_STAGE(PG8_SA(1, 0), cA + kstep, voffA); PG8_STAGE(PG8_SB(1, 1), cB + hstep + kstep, voffB);
        PG8_WAIT_V(6); PG8_BAR;
    } else {
        PG8_STAGE(PG8_SB(0, 0), cB, voffB); PG8_STAGE(PG8_SA(0, 0), cA, voffA); PG8_STAGE(PG8_SB(0, 1), cB + hstep, voffB); PG8_STAGE(PG8_SA(0, 1), cA + hstep, voffA);
        if (wr == 1) PG8_BAR;
        PG8_WAIT_V(4); PG8_BAR;
        PG8_STAGE(PG8_SB(1, 0), cB + kstep, voffB); PG8_STAGE(PG8_SA(1, 0), cA + kstep, voffA); PG8_STAGE(PG8_SB(1, 1), cB + hstep + kstep, voffB);
        PG8_WAIT_V(6); PG8_BAR;
    }
    for (;;) {
        const bool has_next = S.next(ui + 1, nxt);
        const char* nA = has_next ? (const char*)g.A + (size_t)nxt.pm * tstep : cA; const char* nB = has_next ? (const char*)g.Bt + (size_t)nxt.pn * tstep : cB;
        for (int t = 0; t < nt; t += 2) {
            const bool last = (t == nt - 2);
            const char* a1 = cA + (size_t)(t + 1) * kstep;
            const char* a2 = last ? nA : cA + (size_t)(t + 2) * kstep; const char* b2 = last ? nB : cB + (size_t)(t + 2) * kstep;
            const char* a3 = a2 + kstep; const char* b3 = b2 + kstep;
            if (last && has_next) S.a_ready(nxt);
            if constexpr (SP2) {
            PG8_LDB(B0, 0, 0); PG8_LDB(B1, 0, 1); PG8_SCHED; PG8_LDA(At, 0, 0); PG8_STAGE(PG8_SA(1, 1), a1 + hstep, voffA);
            PG8_WAIT_V(8); PG8_WAIT_L(0); PG8_BAR; PG8_MMA(0, 0, At, B0); PG8_MMA(0, 1, At, B1); PG8_BAR; PG8_SCHED;
            PG8_LDA(At, 0, 1); PG8_STAGE(PG8_SB(0, 0), b2, voffB); PG8_STAGE(PG8_SB(0, 1), b2 + hstep, voffB); PG8_STAGE(PG8_SA(0, 0), a2, voffA);
            PG8_WAIT_V(8); PG8_WAIT_L(0); PG8_BAR; PG8_MMA(1, 0, At, B0); PG8_MMA(1, 1, At, B1); PG8_BAR; PG8_SCHED;
            PG8_LDB(B0, 1, 0); PG8_LDB(B1, 1, 1); PG8_SCHED; PG8_LDA(At, 1, 0); PG8_STAGE(PG8_SA(0, 1), a2 + hstep, voffA);
            PG8_WAIT_V(8); PG8_WAIT_L(0); PG8_BAR; PG8_MMA(0, 0, At, B0); PG8_MMA(0, 1, At, B1); PG8_BAR; PG8_SCHED;
            PG8_LDA(At, 1, 1); PG8_STAGE(PG8_SB(1, 0), b3, voffB); PG8_STAGE(PG8_SB(1, 1), b3 + hstep, voffB); PG8_STAGE(PG8_SA(1, 0), a3, voffA);
            PG8_WAIT_V(8); PG8_WAIT_L(0); PG8_BAR; PG8_MMA(1, 0, At, B0); PG8_MMA(1, 1, At, B1); PG8_BAR; PG8_SCHED;
            } else {
            PG8_LDB(B0, 0, 0); PG8_SCHED; PG8_LDA(At, 0, 0); PG8_STAGE(PG8_SA(1, 1), a1 + hstep, voffA);
            PG8_WAIT_L(8); PG8_BAR; PG8_WAIT_L(0); PG8_MMA(0, 0, At, B0); PG8_BAR; PG8_SCHED;
            PG8_LDB(B1, 0, 1); PG8_STAGE(PG8_SB(0, 0), b2, voffB);
            PG8_BAR; PG8_WAIT_L(0); PG8_MMA(0, 1, At, B1); PG8_BAR;
            PG8_LDA(At, 0, 1); PG8_STAGE(PG8_SA(0, 0), a2, voffA);
            PG8_BAR; PG8_WAIT_L(0); PG8_MMA(1, 0, At, B0); PG8_BAR; PG8_SCHED;
            PG8_STAGE(PG8_SB(0, 1), b2 + hstep, voffB);
            PG8_WAIT_V(6); PG8_BAR; PG8_MMA(1, 1, At, B1); PG8_BAR;
            PG8_LDB(B0, 1, 0); PG8_SCHED; PG8_LDA(At, 1, 0); PG8_STAGE(PG8_SA(0, 1), a2 + hstep, voffA);
            PG8_WAIT_L(8); PG8_BAR; PG8_WAIT_L(0); PG8_MMA(0, 0, At, B0); PG8_BAR; PG8_SCHED;
            PG8_LDB(B1, 1, 1); PG8_STAGE(PG8_SB(1, 0), b3, voffB);
            PG8_BAR; PG8_WAIT_L(0); PG8_MMA(0, 1, At, B1); PG8_BAR;
            PG8_LDA(At, 1, 1); PG8_STAGE(PG8_SA(1, 0), a3, voffA);
            PG8_BAR; PG8_WAIT_L(0); PG8_MMA(1, 0, At, B0); PG8_BAR; PG8_SCHED;
            PG8_STAGE(PG8_SB(1, 1), b3 + hstep, voffB);
            PG8_WAIT_V(6); PG8_BAR; PG8_MMA(1, 1, At, B1); PG8_BAR;
            }
        }
        if constexpr (ALIGN_EPI) { if (wr == 0) PG8_BAR; }
        if constexpr (!Epi::AFTER_DRAIN) { E(acc, cur, wr, wc, fr, fq); S.done(cur); }
        if (!has_next) break;
#pragma unroll
        for (int a = 0; a < 2; ++a)
#pragma unroll
            for (int b = 0; b < 2; ++b)
#pragma unroll
                for (int m = 0; m < 4; ++m)
#pragma unroll
                    for (int n = 0; n < 2; ++n) acc[a][b][m][n] = (f32x4){0.f, 0.f, 0.f, 0.f};
        cur = nxt; cA = nA; cB = nB; ++ui;
        if constexpr (ALIGN_EPI) { if (wr == 1) PG8_BAR; }
    }
    PG8_WAIT_V(0);
    if constexpr (!ALIGN_EPI) { if (wr == 0) PG8_BAR; }
    PG8_BAR;
    if constexpr (Epi::AFTER_DRAIN) { E.fused(acc, cur, wr, wc, fr, fq, lds, wid, lane); S.done(cur); }
#undef PG8_SA
#undef PG8_SB
#undef PG8_STAGE
#undef PG8_LDA
#undef PG8_LDB
#undef PG8_MMA
#undef PG8_WAIT_V
#undef PG8_WAIT_L
#undef PG8_BAR
#undef PG8_SCHED
}
}

typedef pg8::bf16_t bf16;
typedef pg8::f32x4 f32x4;
typedef pg8::u32x4 u32x4;
#define LAS __attribute__((address_space(3)))
constexpr int NWAVES = 8, NTHREADS = NWAVES * 64;
constexpr int M = 16384, D = 1024, NIN = 4096, SEQ = 4096, PLE = 256, DEPTH = 2;
constexpr int LDS_BYTES = 131072 + 64 + 1024;
constexpr size_t MiB = 1024 * 1024;
constexpr size_t WS_PROJ = 0;
constexpr size_t WS_VT   = 128 * MiB;
constexpr size_t WS_XB   = 144 * MiB;
constexpr size_t WS_XB2  = 176 * MiB;
constexpr size_t WS_PB   = 208 * MiB;
constexpr size_t WS_WT   = 224 * MiB;
constexpr size_t WT_LAYER = 12 * MiB + 512 * 1024, WT_OUT = 8 * MiB, WT_PG = 10 * MiB, WT_PE = 12 * MiB;
constexpr size_t WS_SS   = 250 * MiB;
constexpr size_t WS_BAR  = 250 * MiB + 512 * 1024;
constexpr size_t WS_BAR_BYTES = 16384;
constexpr size_t WS_END  = 251 * MiB;

struct Args {
    const float* x; const float* p; const float* norm_g; const float* w_in; const float* conv_w; const float* conv_b; const float* branch_g;
    const float* w_out; const float* ple_norm_g; const float* w_pg; const float* b_pg; const float* w_pe; const float* final_g;
    float* out; unsigned char* ws;
};

__device__ __forceinline__ unsigned pk2(float lo, float hi) { return pg8::cvt_pk_bf16(lo, hi); }
__device__ __forceinline__ float bflo(unsigned w) { return __uint_as_float(w << 16); }
__device__ __forceinline__ float bfhi(unsigned w) { return __uint_as_float(w & 0xffff0000u); }
__device__ __forceinline__ float wave_sum(float v) {
#pragma unroll
    for (int o = 1; o < 64; o <<= 1) v += __shfl_xor(v, o);
    return v;
}
__device__ __forceinline__ float silu_f(float v) { return v * __builtin_amdgcn_rcpf(1.0f + __expf(-v)); }

template <bool PERM_IN> __device__ __forceinline__ void p0_transpose_item(const float* W, const float* g, int K, int N, bf16* WT, LAS float* scr, int item, int lane) {
    const int nblk = N / 32, kb = item / nblk, nb = item % nblk, k0 = 64 * kb, n0 = 32 * nb;
    int d0 = n0;
    if (PERM_IN && n0 >= 512 && n0 < 1536) { const int ch = (n0 - 512) & 511, hsel = (n0 - 512) >> 9; d0 = 512 + 256 * (ch >> 7) + 128 * hsel + (ch & 127); }
    float wv[32];
#pragma unroll
    for (int i = 0; i < 32; ++i) wv[i] = __builtin_nontemporal_load(W + (size_t)(k0 + 2 * i + (lane >> 5)) * N + n0 + (lane & 31));
    const float gl = g ? g[k0 + lane] : 1.0f;
#pragma unroll
    for (int i = 0; i < 32; ++i) { const int kk = 2 * i + (lane >> 5); scr[kk * 33 + (lane & 31)] = wv[i] * __shfl(gl, kk); }
    asm volatile("s_waitcnt lgkmcnt(0)" ::: "memory");
    const int c = lane & 7;
#pragma unroll
    for (int j = 0; j < 4; ++j) { const int n = (lane >> 3) + 8 * j; const LAS float* s = scr + (8 * c) * 33 + n;
        u32x4 o; o.x = pk2(s[0 * 33], s[1 * 33]); o.y = pk2(s[2 * 33], s[3 * 33]); o.z = pk2(s[4 * 33], s[5 * 33]); o.w = pk2(s[6 * 33], s[7 * 33]);
        *(u32x4*)(WT + (size_t)(d0 + n) * K + k0 + 8 * c) = o; }
    asm volatile("s_waitcnt lgkmcnt(0)" ::: "memory");
}

template <bool PERM_IN> __device__ __forceinline__ void p0_transpose_piece(const float* W, const float* g, int K, int N, bf16* WT, LAS float* scr, int item, int part, int lane) {
    const int nblk = N / 32, kb = item / nblk, nb = item % nblk, k0 = 64 * kb + 8 * part, n0 = 32 * nb;
    int d0 = n0;
    if (PERM_IN && n0 >= 512 && n0 < 1536) { const int ch = (n0 - 512) & 511, hsel = (n0 - 512) >> 9; d0 = 512 + 256 * (ch >> 7) + 128 * hsel + (ch & 127); }
    float wv[4];
#pragma unroll
    for (int i = 0; i < 4; ++i) wv[i] = __builtin_nontemporal_load(W + (size_t)(k0 + 2 * i + (lane >> 5)) * N + n0 + (lane & 31));
#pragma unroll
    for (int i = 0; i < 4; ++i) { const int kk = 2 * i + (lane >> 5); scr[kk * 33 + (lane & 31)] = wv[i] * (g ? g[k0 + kk] : 1.0f); }
    asm volatile("s_waitcnt lgkmcnt(0)" ::: "memory");
    if (lane < 32) { const LAS float* sp = scr + lane;
        u32x4 o; o.x = pk2(sp[0 * 33], sp[1 * 33]); o.y = pk2(sp[2 * 33], sp[3 * 33]); o.z = pk2(sp[4 * 33], sp[5 * 33]); o.w = pk2(sp[6 * 33], sp[7 * 33]);
        *(u32x4*)(WT + (size_t)(d0 + lane) * K + k0) = o; }
    asm volatile("s_waitcnt lgkmcnt(0)" ::: "memory");
}
typedef const __attribute__((address_space(4))) Args* KArgsP;
__device__ __forceinline__ void p0_prologue(KArgsP Ap, LAS unsigned char* lds, int gw, int NGW, int wave, int lane) {
    LAS float* scr = (LAS float*)(lds + wave * 16384);
    constexpr int I_IN = (D / 64) * (NIN / 32), I_SQ = (D / 64) * (D / 32), I_PE = (PLE / 64) * (D / 32), I_L = I_IN + 2 * I_SQ + I_PE;
    const int n_items = DEPTH * I_L, n_whole = (n_items / NGW) * NGW, n_left = n_items - n_whole;
    for (int it = gw; it < n_whole + 8 * n_left; it += NGW) {
        const bool whole = it < n_whole;
        const int item = whole ? it : n_whole + ((it - n_whole) >> 3), part = (it - n_whole) & 7;
        const int l = item / I_L; int r = item % I_L;
        bf16* wt = (bf16*)(Ap->ws + WS_WT + (size_t)l * WT_LAYER);
        if (r < I_IN) { const float* W = Ap->w_in + (size_t)l * D * NIN; const float* g = Ap->norm_g + l * D;
            if (whole) p0_transpose_item<true>(W, g, D, NIN, wt, scr, r, lane); else p0_transpose_piece<true>(W, g, D, NIN, wt, scr, r, part, lane); continue; } r -= I_IN;
        if (r < I_SQ) { const float* W = Ap->w_out + (size_t)l * D * D; bf16* o = (bf16*)((unsigned char*)wt + WT_OUT);
            if (whole) p0_transpose_item<false>(W, nullptr, D, D, o, scr, r, lane); else p0_transpose_piece<false>(W, nullptr, D, D, o, scr, r, part, lane); continue; } r -= I_SQ;
        if (r < I_SQ) { const float* W = Ap->w_pg + (size_t)l * D * D; const float* g = Ap->ple_norm_g + l * D; bf16* o = (bf16*)((unsigned char*)wt + WT_PG);
            if (whole) p0_transpose_item<false>(W, g, D, D, o, scr, r, lane); else p0_transpose_piece<false>(W, g, D, D, o, scr, r, part, lane); continue; } r -= I_SQ;
        { const float* W = Ap->w_pe + (size_t)l * PLE * D; bf16* o = (bf16*)((unsigned char*)wt + WT_PE);
            if (whole) p0_transpose_item<false>(W, nullptr, PLE, D, o, scr, r, lane); else p0_transpose_piece<false>(W, nullptr, PLE, D, o, scr, r, part, lane); }
    }
    float* ss = (float*)(Ap->ws + WS_SS);
    bf16* xb = (bf16*)(Ap->ws + WS_XB);
    for (int m = gw; m < M; m += 2 * NGW) {
        const int m2 = m + NGW;
        const f32x4* xr = (const f32x4*)(Ap->x + (size_t)m * D) + lane; const f32x4* xr2 = (const f32x4*)(Ap->x + (size_t)m2 * D) + lane;
        unsigned long long* o8 = (unsigned long long*)(xb + (size_t)m * D) + lane; unsigned long long* o82 = (unsigned long long*)(xb + (size_t)m2 * D) + lane;
        f32x4 v[4], w[4];
        const bool two = m2 < M;
#pragma unroll
        for (int j = 0; j < 4; ++j) { v[j] = __builtin_nontemporal_load(xr + 64 * j); w[j] = two ? __builtin_nontemporal_load(xr2 + 64 * j) : v[j]; }
        float s = 0.f, s2 = 0.f;
#pragma unroll
        for (int j = 0; j < 4; ++j) {
            s += (v[j].x * v[j].x + v[j].y * v[j].y) + (v[j].z * v[j].z + v[j].w * v[j].w); s2 += (w[j].x * w[j].x + w[j].y * w[j].y) + (w[j].z * w[j].z + w[j].w * w[j].w);
            o8[64 * j] = (unsigned long long)pk2(v[j].x, v[j].y) | ((unsigned long long)pk2(v[j].z, v[j].w) << 32);
            if (two) o82[64 * j] = (unsigned long long)pk2(w[j].x, w[j].y) | ((unsigned long long)pk2(w[j].z, w[j].w) << 32); }
        s = wave_sum(s); s2 = wave_sum(s2);
        if (lane == 0) { ss[m] = s; if (two) ss[m2] = s2; }
    }
    for (int i = gw * 64 + lane; i < 4 * M; i += NGW * 64) ss[M + i] = 0.f;
    bf16* pb = (bf16*)(Ap->ws + WS_PB);
    for (int i = gw * 64 + lane; i < DEPTH * M * PLE / 8; i += 4 * NGW * 64) {
        f32x4 a[4], b[4];
#pragma unroll
        for (int j = 0; j < 4; ++j) { const size_t c = (size_t)i + (size_t)j * NGW * 64; const size_t e = (c < (size_t)(DEPTH * M * PLE / 8) ? c : (size_t)i) * 8; a[j] = __builtin_nontemporal_load((const f32x4*)(Ap->p + e)); b[j] = __builtin_nontemporal_load((const f32x4*)(Ap->p + e + 4)); }
#pragma unroll
        for (int j = 0; j < 4; ++j) { const size_t c = (size_t)i + (size_t)j * NGW * 64; const size_t e = (c < (size_t)(DEPTH * M * PLE / 8) ? c : (size_t)i) * 8;
            u32x4 w; w.x = pk2(a[j].x, a[j].y); w.y = pk2(a[j].z, a[j].w); w.z = pk2(b[j].x, b[j].y); w.w = pk2(b[j].z, b[j].w);
            *(u32x4*)(pb + e) = w; }
    }
}

__device__ __forceinline__ void unpack8(const u32x4 v, float (&f)[8]) {
    f[0] = bflo(v.x); f[1] = bfhi(v.x); f[2] = bflo(v.y); f[3] = bfhi(v.y); f[4] = bflo(v.z); f[5] = bfhi(v.z); f[6] = bflo(v.w); f[7] = bfhi(v.w);
}
typedef float f2 __attribute__((ext_vector_type(2)));
__device__ __forceinline__ void unpack4(const u32x4 v, f2 (&o)[4]) {
    o[0] = (f2){bflo(v.x), bfhi(v.x)}; o[1] = (f2){bflo(v.y), bfhi(v.y)}; o[2] = (f2){bflo(v.z), bfhi(v.z)}; o[3] = (f2){bflo(v.w), bfhi(v.w)};
}
__device__ __forceinline__ void conv_item(const bf16* P, bf16* Y, const float* cw, const float* cb, const float* bg, int item, int lane) {
    const int t0 = item * 8, c0 = lane * 8;
    const bool first = (t0 & (SEQ - 1)) == 0;
    const int tm2 = first ? t0 : t0 - 2, tm1 = first ? t0 : t0 - 1;
    u32x4 ld[8][3];
    const u32x4 h0 = *(const u32x4*)(P + (size_t)tm2 * 4096 + 512 + c0), h1 = *(const u32x4*)(P + (size_t)tm1 * 4096 + 512 + c0);
#pragma unroll
    for (int tt = 0; tt < 8; ++tt) {
        const bf16* pr = P + (size_t)(t0 + tt) * 4096 + c0;
        ld[tt][0] = *(const u32x4*)(pr); ld[tt][1] = *(const u32x4*)(pr + 512); ld[tt][2] = *(const u32x4*)(pr + 1536);
    }
    f2 w0[4], w1[4], w2[4], bb[4], gg[4];
#pragma unroll
    for (int i = 0; i < 4; ++i) { w0[i] = *(const f2*)(cw + c0 + 2 * i); w1[i] = *(const f2*)(cw + 512 + c0 + 2 * i); w2[i] = *(const f2*)(cw + 1024 + c0 + 2 * i);
        bb[i] = *(const f2*)(cb + c0 + 2 * i); gg[i] = *(const f2*)(bg + c0 + 2 * i); }
    f2 u[3][4];
    unpack4(h0, u[0]); unpack4(h1, u[1]);
    if (first) {
#pragma unroll
        for (int i = 0; i < 4; ++i) { u[0][i] = (f2){0.f, 0.f}; u[1][i] = (f2){0.f, 0.f}; }
    }
#pragma unroll
    for (int tt = 0; tt < 8; ++tt) {
        f2 fb[4], fz[4], y[4];
        unpack4(ld[tt][0], fb); unpack4(ld[tt][1], u[(tt + 2) % 3]); unpack4(ld[tt][2], fz);
        f2 sqv = (f2){0.f, 0.f};
#pragma unroll
        for (int i = 0; i < 4; ++i) { y[i] = fb[i] * (bb[i] + w0[i] * u[tt % 3][i] + w1[i] * u[(tt + 1) % 3][i] + w2[i] * u[(tt + 2) % 3][i]); sqv += y[i] * y[i]; }
        float sq = sqv.x + sqv.y;
        sq += __shfl_xor(sq, 1); sq += __shfl_xor(sq, 2); sq += __shfl_xor(sq, 4);
        const float r = rsqrtf(sq * (1.0f / 64.0f) + pg8::RMS_EPS);
        unsigned ow[4];
#pragma unroll
        for (int i = 0; i < 4; ++i) {
            f2 sg; sg.x = __builtin_amdgcn_rcpf(1.0f + __expf(-fz[i].x)); sg.y = __builtin_amdgcn_rcpf(1.0f + __expf(-fz[i].y));
            const f2 o = (y[i] * (gg[i] * r)) * (fz[i] * sg);
            ow[i] = pk2(o.x, o.y);
        }
        u32x4 w; w.x = ow[0]; w.y = ow[1]; w.z = ow[2]; w.w = ow[3];
        *(u32x4*)(Y + (size_t)(t0 + tt) * 1024 + c0) = w;
    }
}

typedef float f32x16 __attribute__((ext_vector_type(16)));
typedef float f32x2_t __attribute__((ext_vector_type(2)));
typedef __bf16 bf16x2_t __attribute__((ext_vector_type(2)));
typedef unsigned u32x2 __attribute__((ext_vector_type(2)));
__device__ __forceinline__ unsigned cvtpk(float lo, float hi) { f32x2_t v = {lo, hi}; bf16x2_t b = __builtin_convertvector(v, bf16x2_t); return __builtin_bit_cast(unsigned, b); }
#define MFMA32(a, b, c) __builtin_amdgcn_mfma_f32_32x32x16_bf16((a), (b), (c), 0, 0, 0)

typedef short v4i16_t __attribute__((ext_vector_type(4)));
template <bool DIAG>
__device__ __forceinline__ void attn_tile(LAS unsigned char* wl, const int krd, const int ksw, const int vrow, const int vch, const int vf0, const int hh, const int r,
                                          const pg8::bf16x8 (&qf)[4], f32x16& o0, f32x16& o1, float& carry2) {
    pg8::bf16x8 kf[4], vf[2][2];
#pragma unroll
    for (int kk = 0; kk < 4; ++kk) kf[kk] = *(const LAS pg8::bf16x8*)(wl + krd + (((2 * kk + hh) ^ ksw) * 16));
#pragma unroll
    for (int mt = 0; mt < 2; ++mt)
#pragma unroll
        for (int s2 = 0; s2 < 2; ++s2) {
            const v4i16_t lo = __builtin_amdgcn_ds_read_tr16_b64_v4i16((LAS v4i16_t*)(wl + vrow + (8 * s2 + 0) * 128 + (((4 * mt + vch) ^ vf0) * 16)));
            const v4i16_t hi = __builtin_amdgcn_ds_read_tr16_b64_v4i16((LAS v4i16_t*)(wl + vrow + (8 * s2 + 4) * 128 + (((4 * mt + vch) ^ vf0 ^ 4) * 16)));
            vf[mt][s2] = (pg8::bf16x8){lo[0], lo[1], lo[2], lo[3], hi[0], hi[1], hi[2], hi[3]};
        }
    f32x16 z;
#pragma unroll
    for (int i = 0; i < 16; ++i) z[i] = 0.f;
#pragma unroll
    for (int kk = 0; kk < 4; ++kk) z = MFMA32(kf[kk], qf[kk], z);
    float om[16], be[16], pre[16], a[16];
#pragma unroll
    for (int i = 0; i < 16; ++i) {
        const float e = __builtin_amdgcn_fmed3f(__builtin_amdgcn_exp2f(-z[i]), 0.0f, 1.0e30f), rc = __builtin_amdgcn_rcpf(1.0f + e);
        be[i] = rc; om[i] = e * rc;
        if (DIAG) { const bool valid = (16 * hh + i) < r; be[i] = valid ? be[i] : 0.f; om[i] = valid ? om[i] : 1.0f; }
    }
    float run = 1.0f;
#pragma unroll
    for (int i = 15; i >= 0; --i) { pre[i] = run; run *= om[i]; }
    const float tot = run, ptot = __shfl_xor(tot, 32);
    const float sh = __builtin_amdgcn_exp2f(carry2) * (hh == 0 ? ptot : 1.0f);
#pragma unroll
    for (int i = 0; i < 16; ++i) a[i] = be[i] * (pre[i] * sh);
    carry2 += __builtin_amdgcn_logf(tot * ptot);
#pragma unroll
    for (int s2 = 0; s2 < 2; ++s2) {
        u32x4 pw; pw.x = cvtpk(a[8 * s2 + 0], a[8 * s2 + 1]); pw.y = cvtpk(a[8 * s2 + 2], a[8 * s2 + 3]); pw.z = cvtpk(a[8 * s2 + 4], a[8 * s2 + 5]); pw.w = cvtpk(a[8 * s2 + 6], a[8 * s2 + 7]);
        const pg8::bf16x8 pf = __builtin_bit_cast(pg8::bf16x8, pw);
        o0 = MFMA32(vf[0][s2], pf, o0);
        o1 = MFMA32(vf[1][s2], pf, o1);
    }
}
__device__ __forceinline__ void attn_item_mfma(const bf16* P, bf16* Y, const float* bg, LAS unsigned char* wl, int item, int lane) {
    const int bh = item >> 7, qt = item & 127, b = bh >> 3, h = bh & 7, q0 = qt * 32;
    const int r = lane & 31, hh = lane >> 5;
    const bf16* base = P + (size_t)b * SEQ * 4096;
    pg8::bf16x8 qf[4];
    u32x4 kA[4], vA[4], kB[4], vB[4];
    {
        const bf16* qp = base + (size_t)(q0 + r) * 4096 + 2048 + h * 64 + hh * 8;
#pragma unroll
        for (int kk = 0; kk < 4; ++kk) qf[kk] = *(const pg8::bf16x8*)(qp + kk * 16);
    }
    const char* kg = (const char*)(base + (size_t)q0 * 4096 + 2560 + h * 64);
    const unsigned loff = (unsigned)(lane >> 3) * 8192u + (unsigned)(lane & 7) * 16u;
    const int kw = (lane >> 3) * 128 + (((lane & 7) ^ ((lane >> 3) & 7)) * 16);
    const int rw7 = (lane >> 3) & 7;
    const int vw = 4096 + (lane >> 3) * 128 + (((lane & 7) ^ (rw7 ^ (((rw7 >> 1) & 1) << 2))) * 16);
    const int pr = 16 * ((r >> 2) & 1) + (r & 3) + 4 * (r >> 3);
    const int krd = pr * 128, ksw = pr & 7;
    const int tq = (lane & 15) >> 2, tp = lane & 3, tg = (lane >> 4) & 1;
    const int vrow = 4096 + (16 * hh + tq) * 128 + (tp & 1) * 8;
    const int vch = 2 * tg + (tp >> 1);
    const int vf0 = tq ^ (((tq >> 1) & 1) << 2);
#define ATT_LOAD(KR, VR) do { const unsigned long long kq_ = (unsigned long long)kg; \
        const char* ks_ = (const char*)(((unsigned long long)(unsigned)__builtin_amdgcn_readfirstlane((int)(kq_ >> 32)) << 32) | (unsigned)__builtin_amdgcn_readfirstlane((int)kq_)); \
        _Pragma("unroll") for (int i = 0; i < 4; ++i) { KR[i] = *(const u32x4*)(ks_ + i * 65536 + loff); VR[i] = *(const u32x4*)(ks_ + 1024 + i * 65536 + loff); } } while (0)
#define ATT_STAGE(KR, VR) do { _Pragma("unroll") for (int i = 0; i < 4; ++i) { *(LAS u32x4*)(wl + kw + i * 1024) = KR[i]; *(LAS u32x4*)(wl + vw + i * 1024) = VR[i]; } } while (0)
    ATT_LOAD(kA, vA);
    if (q0 >= 32) { kg -= 32 * 8192; ATT_LOAD(kB, vB); }
    f32x16 o0, o1;
#pragma unroll
    for (int i = 0; i < 16; ++i) { o0[i] = 0.f; o1[i] = 0.f; }
    float carry2 = 0.f;
    ATT_STAGE(kA, vA);
    if (q0 >= 64) { kg -= 32 * 8192; ATT_LOAD(kA, vA); }
    attn_tile<true>(wl, krd, ksw, vrow, vch, vf0, hh, r, qf, o0, o1, carry2);
    if (q0 >= 32) {
        for (int k0 = q0 - 32;;) {
            ATT_STAGE(kB, vB);
            if (k0 >= 64) { kg -= 32 * 8192; ATT_LOAD(kB, vB); }
            attn_tile<false>(wl, krd, ksw, vrow, vch, vf0, hh, r, qf, o0, o1, carry2);
            if (k0 < 32) break;
            if (__all(carry2 < -150.1f)) break;
            k0 -= 32;
            ATT_STAGE(kA, vA);
            if (k0 >= 64) { kg -= 32 * 8192; ATT_LOAD(kA, vA); }
            attn_tile<false>(wl, krd, ksw, vrow, vch, vf0, hh, r, qf, o0, o1, carry2);
            if (k0 < 32) break;
            if (__all(carry2 < -150.1f)) break;
            k0 -= 32;
        }
    }
#undef ATT_LOAD
#undef ATT_STAGE
    float sq = 0.f;
#pragma unroll
    for (int i = 0; i < 16; ++i) sq += o0[i] * o0[i] + o1[i] * o1[i];
    sq += __shfl_xor(sq, 32);
    const float rr = rsqrtf(sq * (1.0f / 64.0f) + pg8::RMS_EPS);
    const size_t row = (size_t)b * SEQ + q0 + r;
#pragma unroll
    for (int mt = 0; mt < 2; ++mt)
#pragma unroll
        for (int g = 0; g < 4; ++g) {
            const int d0 = mt * 32 + 8 * g + 4 * hh;
            const u32x2 zw = *(const u32x2*)(P + row * 4096 + 3584 + h * 64 + d0);
            const f32x4 gg = *(const f32x4*)(bg + 512 + h * 64 + d0);
            float y[4];
#pragma unroll
            for (int j = 0; j < 4; ++j) { const float ov = mt == 0 ? o0[4 * g + j] : o1[4 * g + j]; y[j] = ov * rr * gg[j]; }
            y[0] *= silu_f(bflo(zw.x)); y[1] *= silu_f(bfhi(zw.x)); y[2] *= silu_f(bflo(zw.y)); y[3] *= silu_f(bfhi(zw.y));
            u32x2 ow; ow.x = cvtpk(y[0], y[1]); ow.y = cvtpk(y[2], y[3]);
            *(u32x2*)(Y + row * 1024 + 512 + h * 64 + d0) = ow;
        }
}

#define XB_TMO      128
#define XB_XCNT(j)  (256  + 64 * (j))
#define XB_XSUB(j)  (1280 + 64 * (j))
#define XB_XGEN(j)  (2304 + 64 * (j))
#define XB_TOP      3328
#define XB_TOPGEN   3392
#define XCD_BAR_WORDS 3456
#define XB_SPIN_CAP (1u << 18)

__device__ __forceinline__ unsigned xb_ld(unsigned* p)              { return __hip_atomic_load(p, __ATOMIC_RELAXED, __HIP_MEMORY_SCOPE_AGENT); }
__device__ __forceinline__ unsigned xb_add(unsigned* p, unsigned v) { return __hip_atomic_fetch_add(p, v, __ATOMIC_RELAXED, __HIP_MEMORY_SCOPE_AGENT); }
__device__ __forceinline__ unsigned xb_xcc_id() { return (unsigned)__builtin_amdgcn_s_getreg((3 << 11) | 20) & 0xFu; }
#define XB_SPIN(cond, bar) do { unsigned _sp = 0; while (cond) { __builtin_amdgcn_s_sleep(1); \
    if ((++_sp & 255u) == 0u) { if (xb_ld(&(bar)[XB_TMO])) break; if (_sp > XB_SPIN_CAP) { atomicAdd(&(bar)[XB_TMO], 1u); break; } } } } while (0)

struct XcdBarrier {
    unsigned* bar; unsigned x;
    volatile LAS unsigned* st;
};

__device__ __forceinline__ XcdBarrier xcd_barrier_post(unsigned* bar, volatile LAS unsigned* st) {
    XcdBarrier b; b.bar = bar; b.x = xb_xcc_id(); b.st = st;
    if (threadIdx.x == 0) (void)xb_add(&bar[XB_XCNT(b.x)], 1u);
    return b;
}
__device__ __forceinline__ void xcd_barrier_complete(unsigned* bar, unsigned x, unsigned& nloc, unsigned& nx) {
    const unsigned G = gridDim.x * gridDim.y * gridDim.z;
    unsigned sum, cnt, mine, sp = 0u;
    for (;;) {
        sum = 0u; cnt = 0u; mine = 0u;
#pragma unroll
        for (unsigned j = 0; j < 16; ++j) { const unsigned c = xb_ld(&bar[XB_XCNT(j)]); sum += c; cnt += (c > 0u) ? 1u : 0u; mine = (j == x) ? c : mine; }
        if (sum == G) break;
        __builtin_amdgcn_s_sleep(1);
        if ((++sp & 255u) == 0u) { if (xb_ld(&bar[XB_TMO])) break; if (sp > XB_SPIN_CAP) { atomicAdd(&bar[XB_TMO], 1u); break; } }
    }
    nloc = mine > 0u ? mine : 1u; nx = cnt > 0u ? cnt : 1u;
}

__device__ __forceinline__ void xcd_barrier(const XcdBarrier& b) {
    asm volatile("s_waitcnt vmcnt(0)" ::: "memory");
    __syncthreads();
    if (threadIdx.x == 0) {
        unsigned* bar = b.bar;
        __builtin_amdgcn_s_waitcnt(0);
        unsigned nloc = b.st[0], nx = b.st[1];
        if (nloc == 0u) { xcd_barrier_complete(bar, b.x, nloc, nx); b.st[0] = nloc; b.st[1] = nx; }
        const unsigned old = xb_add(&bar[XB_XSUB(b.x)], 1u);
        const unsigned gen = old / nloc;
        if (old + 1u == (gen + 1u) * nloc) {
            __builtin_amdgcn_fence(__ATOMIC_RELEASE, "agent");
            asm volatile("s_waitcnt vmcnt(0)" ::: "memory");
            const unsigned og = xb_add(&bar[XB_TOP], 1u);
            const unsigned tg = og / nx;
            if (og + 1u == (tg + 1u) * nx) xb_add(&bar[XB_TOPGEN], 1u);
            else XB_SPIN(xb_ld(&bar[XB_TOPGEN]) == tg, bar);
            __builtin_amdgcn_fence(__ATOMIC_ACQUIRE, "agent");
            xb_add(&bar[XB_XGEN(b.x)], 1u);
            asm volatile("s_waitcnt vmcnt(0)" ::: "memory");
        } else {
            XB_SPIN(xb_ld(&bar[XB_XGEN(b.x)]) == gen, bar);
            __builtin_amdgcn_fence(__ATOMIC_ACQUIRE, "agent");
            asm volatile("s_waitcnt vmcnt(0)" ::: "memory");
        }
    }
    __syncthreads();
}


typedef const __attribute__((address_space(4))) Args* KArgs;
__device__ __forceinline__ KArgs kargs() { KArgs p = (KArgs)__builtin_amdgcn_kernarg_segment_ptr(); asm volatile("" : "+s"(p)); return p; }
__device__ __forceinline__ int opaque_tid() { int t = threadIdx.x; asm volatile("" : "+v"(t)); return t; }

__global__ void __launch_bounds__(NTHREADS, 2) sb_fwd(Args A_unused) {
    extern __shared__ __attribute__((aligned(16))) unsigned char lds_raw[];
    cg::grid_group grid = cg::this_grid();
    LAS unsigned char* lds = (LAS unsigned char*)lds_raw;
    if (gridDim.y == 0x7fffu) grid.sync();
    volatile LAS unsigned* bst = (volatile LAS unsigned*)(lds + 131072);
    if (threadIdx.x < 16) bst[threadIdx.x] = 0u;
    __syncthreads();
    XcdBarrier bar;
    { KArgs ka = kargs(); bar = xcd_barrier_post((unsigned*)(ka->ws + WS_BAR), bst); }

    {
        KArgs ka = kargs(); const int tid = opaque_tid(), lane = tid & 63, wave = __builtin_amdgcn_readfirstlane(tid >> 6);
        const int G = gridDim.x, gw = blockIdx.x * NWAVES + wave, NGW = G * NWAVES;
        p0_prologue(ka, lds, gw, NGW, wave, lane);
    }
    GRID_SYNC();

#pragma unroll 1
    for (int l = 0; l < DEPTH; ++l) {
        {
            KArgs ka = kargs(); unsigned char* ws = ka->ws; const int G = gridDim.x;
            pg8::Gemm g{(const bf16*)(ws + (l == 0 ? WS_XB : WS_XB2)), (const bf16*)(ws + WS_WT + (size_t)l * WT_LAYER), M, NIN, D};
            pg8::StaticOrder S; S.init(M, NIN, G, (int)blockIdx.x);
            const float* ssl = (const float*)(ws + WS_SS) + (size_t)(2 * l) * M;
            LAS float* rtab = (LAS float*)(lds + 131072 + 64);
            pg8::Unit u0; int pm0 = -1;
            if (S.next(0, u0)) { pm0 = u0.pm; const int t = opaque_tid(); if (t < 256) rtab[t] = rsqrtf(ssl[pm0 * 256 + t] * (1.0f / 1024.0f) + pg8::RMS_EPS); }
            __syncthreads();
            pg8::EpiProj E{(bf16*)(ws + WS_PROJ), ssl, rtab, pm0};
            pg8::gemm_phase<pg8::EpiProj, pg8::StaticOrder, true, true>(lds, g, S, E);
        }
        GRID_SYNC();
        {
            KArgs ka = kargs(); unsigned char* ws = ka->ws; const int tid = opaque_tid(), lane = tid & 63, wave = __builtin_amdgcn_readfirstlane(tid >> 6);
            const int G = gridDim.x, gw = blockIdx.x * NWAVES + wave, NGW = G * NWAVES;
            const bf16* PROJ = (const bf16*)(ws + WS_PROJ); bf16* Y = (bf16*)ka->out;
            const float* cw = ka->conv_w + (size_t)l * 3 * 512; const float* cb = ka->conv_b + (size_t)l * 512; const float* bg = ka->branch_g + (size_t)l * 1024;
            const bool conv_first = ((wave >> 2) & 1) == 0;
            const bool loc = (G == 256);
            if (conv_first) for (int it = gw; it < M / 8; it += NGW) conv_item(PROJ, Y, cw, cb, bg, loc ? 256 * ((it >> 3) & 7) + ((it >> 6) << 3) + (it & 7) : it, lane);
            for (int it = gw; it < 32 * 128; it += NGW) {
                int item = it;
                if (loc) { const int xcd = (it >> 3) & 7, j = (((it & 2047) >> 6) << 3) + (it & 7) + 256 * (it >> 11);
                    item = ((((xcd >> 1) * 8) + (j >> 6)) << 7) | ((xcd & 1) * 64 + (j & 63)); }
                attn_item_mfma(PROJ, Y, bg, lds + wave * 8192, item, lane);
            }
            if (!conv_first) for (int it = gw; it < M / 8; it += NGW) conv_item(PROJ, Y, cw, cb, bg, loc ? 256 * ((it >> 3) & 7) + ((it >> 6) << 3) + (it & 7) : it, lane);
        }
        GRID_SYNC();
        {
            KArgs ka = kargs(); unsigned char* ws = ka->ws; const int G = gridDim.x;
            pg8::Gemm g{(const bf16*)ka->out, (const bf16*)(ws + WS_WT + (size_t)l * WT_LAYER + WT_OUT), M, D, D};
            pg8::StaticOrder S; S.init(M, D, G, (int)blockIdx.x);
            float* ssn = (float*)(ws + WS_SS) + (size_t)(2 * l + 1) * M;
            if (l == 0) { pg8::EpiOut<false> E{ka->x, nullptr, (bf16*)(ws + WS_XB), ssn}; pg8::gemm_phase<pg8::EpiOut<false>, pg8::StaticOrder, true, true>(lds, g, S, E); }
            else        { pg8::EpiOut<true> E{nullptr, (const bf16*)(ws + WS_XB2), (bf16*)(ws + WS_XB), ssn}; pg8::gemm_phase<pg8::EpiOut<true>, pg8::StaticOrder, true, true>(lds, g, S, E); }
        }
        {
            KArgs ka = kargs(); unsigned char* ws = ka->ws; const int G = gridDim.x;
            pg8::Gemm g2{(const bf16*)(ws + WS_PB) + (size_t)l * M * PLE, (const bf16*)(ws + WS_WT + (size_t)l * WT_LAYER + WT_PE), M, D, PLE};
            pg8::StaticOrder S; S.init(M, D, G, (int)blockIdx.x);
            pg8::EpiPlain E2{(bf16*)(ws + WS_PROJ), D};
            pg8::gemm_phase<pg8::EpiPlain, pg8::StaticOrder, true, true>(lds, g2, S, E2);
        }
        GRID_SYNC();
        {
            KArgs ka = kargs(); unsigned char* ws = ka->ws; const int G = gridDim.x;
            pg8::Gemm g{(const bf16*)(ws + WS_XB), (const bf16*)(ws + WS_WT + (size_t)l * WT_LAYER + WT_PG), M, D, D};
            pg8::StaticOrder S; S.init(M, D, G, (int)blockIdx.x);
            float* SS = (float*)(ws + WS_SS);
            pg8::EpiPg E{(const bf16*)(ws + WS_XB), (float*)nullptr, (bf16*)(ws + WS_XB2), SS + (size_t)(2 * l + 1) * M, SS + (size_t)(2 * l + 2) * M, ka->b_pg + (size_t)l * D, (const bf16*)(ws + WS_PROJ)};
            pg8::gemm_phase<pg8::EpiPg, pg8::StaticOrder, true, true>(lds, g, S, E);
        }
        GRID_SYNC();
    }
    {
        KArgs ka = kargs(); const int tid = opaque_tid(), lane = tid & 63, wave = __builtin_amdgcn_readfirstlane(tid >> 6);
        const int G = gridDim.x, gw = blockIdx.x * NWAVES + wave, NGW = G * NWAVES;
        const float* ssf = (const float*)(ka->ws + WS_SS) + (size_t)(2 * DEPTH) * M;
        const bf16* xs = (const bf16*)(ka->ws + WS_XB2);
        float* out = ka->out;
        f32x4 gv[4];
#pragma unroll
        for (int j = 0; j < 4; ++j) gv[j] = ((const f32x4*)ka->final_g)[4 * lane + j];
        for (int m = gw; m < M; m += 4 * NGW) {
            u32x4 w[4][2]; float r[4];
#pragma unroll
            for (int q = 0; q < 4; ++q) { const int mq = (m + q * NGW < M) ? m + q * NGW : m;
                const u32x4* xr = (const u32x4*)(xs + (size_t)mq * D) + 2 * lane; w[q][0] = xr[0]; w[q][1] = xr[1];
                r[q] = rsqrtf(ssf[mq] * (1.0f / 1024.0f) + pg8::RMS_EPS); }
#pragma unroll
            for (int q = 0; q < 4; ++q) { if (m + q * NGW < M) {
                f32x4* o = (f32x4*)(out + (size_t)(m + q * NGW) * D) + 4 * lane;
                const u32x4 a = w[q][0], b = w[q][1];
                o[0] = (f32x4){bflo(a.x), bfhi(a.x), bflo(a.y), bfhi(a.y)} * r[q] * gv[0];
                o[1] = (f32x4){bflo(a.z), bfhi(a.z), bflo(a.w), bfhi(a.w)} * r[q] * gv[1];
                o[2] = (f32x4){bflo(b.x), bfhi(b.x), bflo(b.y), bfhi(b.y)} * r[q] * gv[2];
                o[3] = (f32x4){bflo(b.z), bfhi(b.z), bflo(b.w), bfhi(b.w)} * r[q] * gv[3]; } }
        }
    }
}

extern "C" void kernel_launch(void* const* d_in, const int* in_sizes, int n_in, void* d_out, int out_size, void* d_ws, size_t ws_size, hipStream_t stream) {
    static int grid = 0;
    if (grid == 0) {
        if (n_in != 13 || in_sizes[0] != M * D || out_size != M * D || ws_size < WS_END) { fprintf(stderr, "kernel_launch: unexpected shapes / workspace (%d inputs, ws %zu)\n", n_in, ws_size); grid = -1; return; }
        int dev = 0, cus = 0, per_cu = 0;
        if (hipGetDevice(&dev) != hipSuccess || hipDeviceGetAttribute(&cus, hipDeviceAttributeMultiprocessorCount, dev) != hipSuccess) { grid = -1; return; }
        if (hipFuncSetAttribute((const void*)sb_fwd, hipFuncAttributeMaxDynamicSharedMemorySize, LDS_BYTES) != hipSuccess) { fprintf(stderr, "kernel_launch: hipFuncSetAttribute failed\n"); grid = -1; return; }
        if (hipOccupancyMaxActiveBlocksPerMultiprocessor(&per_cu, (const void*)sb_fwd, NTHREADS, LDS_BYTES) != hipSuccess || per_cu < 1) { fprintf(stderr, "kernel_launch: occupancy query gave %d\n", per_cu); (void)hipGetLastError(); grid = -1; return; }
        grid = cus * per_cu;
    }
    if (grid < 0) return;
    if (hipMemsetAsync((char*)d_ws + WS_BAR, 0, WS_BAR_BYTES, stream) != hipSuccess) { fprintf(stderr, "kernel_launch: memset of the barrier words failed\n"); return; }
    Args a{};
    a.x = (const float*)d_in[0]; a.p = (const float*)d_in[1]; a.norm_g = (const float*)d_in[2]; a.w_in = (const float*)d_in[3]; a.conv_w = (const float*)d_in[4];
    a.conv_b = (const float*)d_in[5]; a.branch_g = (const float*)d_in[6]; a.w_out = (const float*)d_in[7]; a.ple_norm_g = (const float*)d_in[8]; a.w_pg = (const float*)d_in[9];
    a.b_pg = (const float*)d_in[10]; a.w_pe = (const float*)d_in[11]; a.final_g = (const float*)d_in[12];
    a.out = (float*)d_out; a.ws = (unsigned char*)d_ws;
    void* args[] = {&a};
    hipError_t e = hipLaunchCooperativeKernel((const void*)sb_fwd, dim3(grid), dim3(NTHREADS), args, LDS_BYTES, stream);
    if (e != hipSuccess) fprintf(stderr, "kernel_launch: cooperative launch failed: %s (grid %d)\n", hipGetErrorString(e), grid);
}
```
